# Optimizing an MI355X kernel written in HIP

```python
import math
import jax, jax.numpy as jnp
from jax import lax
import numpy as np

D_MODEL = 1024
BATCH = 2
SEQ = 8192
DEPTH = 2

D_INNER = D_MODEL
HEAD_DIM = 64
N_HEADS = D_INNER // HEAD_DIM
N_MIXERS = 2
GRID_W = 64
NA_ROWS = 8
NA_COLS = 16
NA_QBLOCK = 16
NA_KBLOCK = NA_QBLOCK + NA_COLS
DIL_PAIRS = ((128, 1), (512, 4), (2048, 16))
N_DIL_GROUPS = len(DIL_PAIRS)
RMS_EPS = 1e-6
NEG_INF = -1e30

kernel_name = "hybrid_natten_dilated_encoder"


def rmsnorm(x, g):
    xf = x.astype(jnp.float32)
    y = xf * lax.rsqrt(jnp.mean(xf * xf, axis=-1, keepdims=True) + RMS_EPS)
    return (y * g.astype(jnp.float32)).astype(x.dtype)


def alibi_slopes(n_heads):
    return jnp.asarray(2.0 ** (-8.0 * (np.arange(n_heads) + 1) / n_heads), dtype=jnp.float32)


def neighbourhood_attention(q, k, v, rpb):
    B, S, H, hd = q.shape
    rows = S // GRID_W
    kh = min(NA_ROWS, rows)
    kw = NA_COLS
    nb = GRID_W // NA_QBLOCK
    scale = 1.0 / math.sqrt(hd)
    qg = q.reshape(B, rows, GRID_W, H, hd)
    kg = k.reshape(B, rows, GRID_W, H, hd)
    vg = v.reshape(B, rows, GRID_W, H, hd)

    blk = np.arange(nb)
    kb_start = np.clip(blk * NA_QBLOCK - kw // 2, 0, GRID_W - NA_KBLOCK)
    col_idx = kb_start[:, None] + np.arange(NA_KBLOCK)[None, :]
    q_col = blk[:, None] * NA_QBLOCK + np.arange(NA_QBLOCK)[None, :]
    q_cstart = np.clip(q_col - kw // 2, 0, GRID_W - kw)
    kcol = col_idx[:, None, :]
    col_valid = (kcol >= q_cstart[:, :, None]) & (kcol < q_cstart[:, :, None] + kw)
    col_off = np.clip(kcol - q_col[:, :, None] + NA_COLS - 1, 0, 2 * NA_COLS - 2)
    col_bias = rpb.astype(jnp.float32)[:, :, col_off]
    col_valid = jnp.asarray(col_valid)[:, :, None, :]

    def row_fn(r):
        rs = jnp.clip(r - kh // 2, 0, rows - kh)
        qr = lax.dynamic_index_in_dim(qg, r, axis=1, keepdims=False).reshape(B, nb, NA_QBLOCK, H, hd)
        kr = lax.dynamic_slice_in_dim(kg, rs, kh, axis=1)[:, :, col_idx]
        vr = lax.dynamic_slice_in_dim(vg, rs, kh, axis=1)[:, :, col_idx]
        s = jnp.einsum('bnqhd,bknjhd->bhnqkj', qr, kr).astype(jnp.float32) * scale
        row_off = rs + jnp.arange(kh) - r + NA_ROWS - 1
        bias = jnp.take(col_bias, row_off, axis=1).transpose(0, 2, 3, 1, 4)
        s = jnp.where(col_valid[None, None], s + bias[None], NEG_INF)
        p = jax.nn.softmax(s.reshape(B, H, nb, NA_QBLOCK, kh * NA_KBLOCK), axis=-1)
        p = p.reshape(B, H, nb, NA_QBLOCK, kh, NA_KBLOCK).astype(v.dtype)
        o = jnp.einsum('bhnqkj,bknjhd->bnqhd', p, vr)
        return o.reshape(B, GRID_W, H, hd)

    out = lax.map(row_fn, jnp.arange(rows))
    return out.transpose(1, 0, 2, 3, 4).reshape(B, S, H, hd)


def dilated_attention(q, k, v, dil, radius, slopes):
    B, S, H, hd = q.shape
    L = S // dil
    C = radius
    nc = -(-L // C)
    lp = nc * C
    scale = 1.0 / math.sqrt(hd)
    qs = jnp.pad(q.reshape(B, L, dil, H, hd), ((0, 0), (0, lp - L), (0, 0), (0, 0), (0, 0)))
    qc = qs.reshape(B, nc, C, dil, H, hd)

    def band(a):
        a = jnp.pad(a.reshape(B, L, dil, H, hd), ((0, 0), (C, lp - L + C), (0, 0), (0, 0), (0, 0)))
        a = a.reshape(B, nc + 2, C, dil, H, hd)
        return jnp.concatenate([a[:, :-2], a[:, 1:-1], a[:, 2:]], axis=2)

    kc, vc = band(k), band(v)
    s = jnp.einsum('bncrhd,bnjrhd->bhrncj', qc, kc).astype(jnp.float32) * scale
    q_i = np.arange(nc)[:, None] * C + np.arange(C)[None, :]
    k_i = (np.arange(nc)[:, None] - 1) * C + np.arange(3 * C)[None, :]
    delta = k_i[:, None, :] - q_i[:, :, None]
    valid = jnp.asarray((np.abs(delta) <= radius) & (k_i[:, None, :] >= 0) & (k_i[:, None, :] < L))
    dist = jnp.asarray(np.abs(delta) * dil, dtype=jnp.float32)
    bias = -slopes[:, None, None, None] * dist[None]
    s = jnp.where(valid[None, None, None], s + bias[None, :, None], NEG_INF)
    lse = jax.nn.logsumexp(s, axis=-1)
    p = jnp.exp(s - lse[..., None]).astype(v.dtype)
    o = jnp.einsum('bhrncj,bnjrhd->bncrhd', p, vc)
    o = o.reshape(B, lp, dil, H, hd)[:, :L].reshape(B, S, H, hd)
    lse = lse.transpose(0, 3, 4, 2, 1).reshape(B, lp, dil, H)[:, :L].reshape(B, S, H)
    return o, lse


def neighbourhood_mixer(h, w_in, rpb):
    B, S, _ = h.shape
    proj = h @ w_in
    q, k, v, gate = jnp.split(proj, 4, axis=-1)
    heads = lambda a: a.reshape(B, S, N_HEADS, HEAD_DIM)
    o = neighbourhood_attention(heads(q), heads(k), heads(v), rpb)
    return o.reshape(B, S, D_INNER), gate


def dilated_mixer(h, w_in):
    B, S, _ = h.shape
    proj = h @ w_in
    qkv = proj[..., :3 * N_DIL_GROUPS * D_INNER].reshape(B, S, N_DIL_GROUPS, 3, N_HEADS, HEAD_DIM)
    gate = proj[..., 3 * N_DIL_GROUPS * D_INNER:]
    slopes = alibi_slopes(N_HEADS)
    outs, lses = [], []
    for g, (window, dil) in enumerate(DIL_PAIRS):
        o_g, lse_g = dilated_attention(qkv[:, :, g, 0], qkv[:, :, g, 1], qkv[:, :, g, 2],
                                       dil, window // (2 * dil), slopes)
        outs.append(o_g)
        lses.append(lse_g)
    wts = jax.nn.softmax(jnp.stack(lses, axis=0), axis=0)
    o = jnp.einsum('gbsh,gbshd->bshd', wts, jnp.stack(outs, axis=0).astype(jnp.float32))
    return o.astype(h.dtype).reshape(B, S, D_INNER), gate


def setup_inputs(seed: int = 0) -> dict:
    key = jax.random.key(seed)
    ks = jax.random.split(key, 10)
    f32 = jnp.float32
    n_in_a = 4 * D_INNER
    n_in_b = (3 * N_DIL_GROUPS + 1) * D_INNER
    return {
        "x": jax.random.normal(ks[0], (BATCH, SEQ, D_MODEL), f32),
        "norm_0": 1.0 + 0.02 * jax.random.normal(ks[1], (D_MODEL,), f32),
        "w_in_0": jax.random.normal(ks[2], (D_MODEL, n_in_a), f32) * D_MODEL ** -0.5,
        "rpb_0": 0.02 * jax.random.normal(ks[3], (N_HEADS, 2 * NA_ROWS - 1, 2 * NA_COLS - 1), f32),
        "w_out_0": jax.random.normal(ks[4], (D_INNER, D_MODEL), f32) * D_INNER ** -0.5,
        "norm_1": 1.0 + 0.02 * jax.random.normal(ks[5], (D_MODEL,), f32),
        "w_in_1": jax.random.normal(ks[6], (D_MODEL, n_in_b), f32) * D_MODEL ** -0.5,
        "w_out_1": jax.random.normal(ks[7], (D_INNER, D_MODEL), f32) * D_INNER ** -0.5,
        "norm_f": 1.0 + 0.02 * jax.random.normal(ks[8], (D_MODEL,), f32),
    }


def reference(x, norm_0, w_in_0, rpb_0, w_out_0, norm_1, w_in_1, w_out_1, norm_f):
    layers = ((norm_0, w_in_0, rpb_0, w_out_0), (norm_1, w_in_1, None, w_out_1))
    for i in range(DEPTH):
        g, w_in, rpb, w_out = layers[i]
        h = rmsnorm(x, g)
        if i % N_MIXERS == 0:
            o, gate = neighbourhood_mixer(h, w_in, rpb)
        else:
            o, gate = dilated_mixer(h, w_in)
        x = x + (o * jax.nn.silu(gate)) @ w_out
    return rmsnorm(x, norm_f)
```

```cpp
#include <hip/hip_runtime.h>
#include <cstdio>
#include <cstdint>

#ifndef FAST_GEMM
#define FAST_GEMM 1
#endif
#ifndef FAST_ATTN_A
#define FAST_ATTN_A 1
#endif
#ifndef FAST_ATTN_B
#define FAST_ATTN_B 1
#endif

#define GAS __attribute__((address_space(1)))
#define LAS __attribute__((address_space(3)))
typedef unsigned short bf16;
typedef unsigned v4u __attribute__((ext_vector_type(4)));
typedef unsigned v2u __attribute__((ext_vector_type(2)));
typedef float f32x4 __attribute__((ext_vector_type(4)));
typedef float f32x2 __attribute__((ext_vector_type(2)));
typedef short bf16x8 __attribute__((ext_vector_type(8)));
typedef GAS unsigned gu32;

constexpr int NWAVES = 8;
constexpr int BATCH = 2, SEQ = 8192, D = 1024, H = 16, HD = 64;
constexpr int M = BATCH * SEQ;
constexpr int N0 = 4096, N1 = 10240;
constexpr int LDQ0 = 3072, LDQ1 = 7168;
constexpr float RMS_EPS = 1e-6f;
constexpr float LOG2E = 1.4426950408889634f;
constexpr float QSCALE = 0.125f * LOG2E;

constexpr size_t MiB = 1u << 20;
constexpr size_t WS_CTL = 0, CTL_ZERO_BYTES = 65536;
constexpr size_t WS_WT0 = 1 * MiB;
constexpr size_t WS_WO0 = 9 * MiB;
constexpr size_t WS_WT1 = 11 * MiB;
constexpr size_t WS_WO1 = 31 * MiB;
constexpr size_t WS_SS1 = 33 * MiB;
constexpr size_t WS_SS2 = 34 * MiB;
constexpr size_t WS_XB = 36 * MiB;
constexpr size_t WS_BIG = 68 * MiB;
constexpr size_t WS_QKG0 = WS_BIG;
constexpr size_t WS_VT0 = WS_BIG + 96 * MiB;
constexpr size_t WS_OG0 = WS_BIG + 128 * MiB;
constexpr size_t WS_QKG1 = WS_BIG;
constexpr size_t WS_VT1 = WS_BIG + 112 * MiB;
constexpr size_t WS_OG1A = WS_BIG + 160 * MiB;
constexpr size_t WS_OG1B = WS_XB;
constexpr size_t WS_END = WS_BIG + 176 * MiB;
static_assert(WS_END <= 256 * MiB, "ws map");

constexpr int RING_BYTES = 131072;
constexpr int MISC_OFF = RING_BYTES;
constexpr int LSE_OFF = RING_BYTES + 512;
constexpr int LDS_BYTES = 147456;
static_assert(LSE_OFF + 4096 <= LDS_BYTES, "lds map");

#define RLX_AGENT __ATOMIC_RELAXED, __HIP_MEMORY_SCOPE_AGENT
#define LDS_WAIT() asm volatile("s_waitcnt lgkmcnt(0)" ::: "memory")
#define VM_WAIT() asm volatile("s_waitcnt vmcnt(0)" ::: "memory")
__device__ __forceinline__ unsigned f2bf(float f) { unsigned u = __builtin_bit_cast(unsigned, f); return (u + 0x7fffu + ((u >> 16) & 1u)) >> 16; }
__device__ __forceinline__ unsigned pk2(float lo, float hi) { return f2bf(lo) | (f2bf(hi) << 16); }
__device__ __forceinline__ float bf2f(unsigned short b) { return __builtin_bit_cast(float, (unsigned)b << 16); }
__device__ __forceinline__ float bflo(unsigned w) { return __builtin_bit_cast(float, w << 16); }
__device__ __forceinline__ float bfhi(unsigned w) { return __builtin_bit_cast(float, w & 0xffff0000u); }
__device__ __forceinline__ unsigned cvt_pk_bf16(float lo, float hi) { unsigned r; asm volatile("v_cvt_pk_bf16_f32 %0, %1, %2" : "=v"(r) : "v"(lo), "v"(hi)); return r; }
__device__ __forceinline__ float wave_sum(float v) {
#pragma unroll
    for (int o = 1; o < 64; o <<= 1) v += __shfl_xor(v, o);
    return v;
}
__device__ __forceinline__ float fast_exp2(float x) { return __builtin_amdgcn_exp2f(x); }
__device__ __forceinline__ float silu_f(float g) { return g * __builtin_amdgcn_rcpf(1.0f + fast_exp2(-g * LOG2E)); }
__device__ __forceinline__ float rstd16(const float* ss, int tok) {
    float s = 0.f;
#pragma unroll
    for (int p = 0; p < 16; ++p) s += ss[p * M + tok];
    return __builtin_amdgcn_rsqf(s * (1.0f / D) + RMS_EPS);
}

#define XB_TMO      128
#define XB_XCNT(j)  (256  + 64 * (j))
#define XB_XSUB(j)  (1280 + 64 * (j))
#define XB_XGEN(j)  (2304 + 64 * (j))
#define XB_TOP      3328
#define XB_TOPGEN   3392
#define XCD_BAR_WORDS 3456
#define XB_SPIN_CAP (1u << 20)
__device__ __forceinline__ unsigned xb_ld(unsigned* p)              { return __hip_atomic_load(p, __ATOMIC_RELAXED, __HIP_MEMORY_SCOPE_AGENT); }
__device__ __forceinline__ unsigned xb_add(unsigned* p, unsigned v) { return __hip_atomic_fetch_add(p, v, __ATOMIC_RELAXED, __HIP_MEMORY_SCOPE_AGENT); }
__device__ __forceinline__ unsigned xb_xcc_id() { return (unsigned)__builtin_amdgcn_s_getreg((3 << 11) | 20) & 0xFu; }
#define XB_SPIN(cond, bar) do { unsigned _sp = 0; while (cond) { __builtin_amdgcn_s_sleep(1); \
    if ((++_sp & 255u) == 0u) { if (xb_ld(&(bar)[XB_TMO])) break; if (_sp > XB_SPIN_CAP) { atomicAdd(&(bar)[XB_TMO], 1u); break; } } } } while (0)
struct XcdBarrier { unsigned* bar; unsigned x; volatile LAS unsigned* st; };
__device__ __forceinline__ XcdBarrier xcd_barrier_post(unsigned* bar, volatile LAS unsigned* st) {
    XcdBarrier b; b.bar = bar; b.x = xb_xcc_id(); b.st = st;
    if (threadIdx.x == 0) (void)xb_add(&bar[XB_XCNT(b.x)], 1u);
    return b;
}
__device__ __forceinline__ void xcd_barrier_complete(unsigned* bar, unsigned x, unsigned& nloc, unsigned& nx) {
    const unsigned G = gridDim.x * gridDim.y * gridDim.z;
    unsigned sum, cnt, mine, sp = 0u;
    for (;;) {
        sum = 0u; cnt = 0u; mine = 0u;
#pragma unroll
        for (unsigned j = 0; j < 16; ++j) { const unsigned c = xb_ld(&bar[XB_XCNT(j)]); sum += c; cnt += (c > 0u) ? 1u : 0u; mine = (j == x) ? c : mine; }
        if (sum == G) break;
        __builtin_amdgcn_s_sleep(1);
        if ((++sp & 255u) == 0u) { if (xb_ld(&bar[XB_TMO])) break; if (sp > XB_SPIN_CAP) { atomicAdd(&bar[XB_TMO], 1u); break; } }
    }
    nloc = mine > 0u ? mine : 1u; nx = cnt > 0u ? cnt : 1u;
}
__device__ __forceinline__ void xcd_barrier(const XcdBarrier& b) {
    asm volatile("s_waitcnt vmcnt(0)" ::: "memory");
    __syncthreads();
    if (threadIdx.x == 0) {
        unsigned* bar = b.bar; unsigned bx = b.x; asm volatile("" : "+s"(bar), "+s"(bx));
        __builtin_amdgcn_s_waitcnt(0);
        unsigned nloc = b.st[0], nx = b.st[1];
        if (nloc == 0u) { xcd_barrier_complete(bar, bx, nloc, nx); b.st[0] = nloc; b.st[1] = nx; }
        const unsigned old = xb_add(&bar[XB_XSUB(bx)], 1u);
        const unsigned gen = old / nloc;
        if (old + 1u == (gen + 1u) * nloc) {
            __builtin_amdgcn_fence(__ATOMIC_RELEASE, "agent");
            asm volatile("s_waitcnt vmcnt(0)" ::: "memory");
            const unsigned og = xb_add(&bar[XB_TOP], 1u);
            const unsigned tg = og / nx;
            if (og + 1u == (tg + 1u) * nx) xb_add(&bar[XB_TOPGEN], 1u);
            else XB_SPIN(xb_ld(&bar[XB_TOPGEN]) == tg, bar);
            __builtin_amdgcn_fence(__ATOMIC_ACQUIRE, "agent");
            xb_add(&bar[XB_XGEN(bx)], 1u);
            asm volatile("s_waitcnt vmcnt(0)" ::: "memory");
        } else {
            XB_SPIN(xb_ld(&bar[XB_XGEN(bx)]) == gen, bar);
            __builtin_amdgcn_fence(__ATOMIC_ACQUIRE, "agent");
            asm volatile("s_waitcnt vmcnt(0)" ::: "memory");
        }
    }
    __syncthreads();
}

constexpr int BM = 256, BK = 64, HALF = 128, HTB = HALF * BK * 2, NXCD = 8, WGM = 8, KDIM = 1024;
__device__ __forceinline__ int lds_byte(int r, int c) { const int st = (r >> 4) * 2 + (c >> 5), rr = r & 15, cc = c & 31, ob = rr * 64 + cc * 2; return st * 1024 + (ob ^ (((ob >> 9) & 1) << 5)); }
__device__ __forceinline__ void stage_rc(int b, int& R, int& C) { const int st = b / 1024, sb = b % 1024, swz = sb ^ (((sb >> 9) & 1) << 5); R = (st >> 1) * 16 + swz / 64; C = (st & 1) * 32 + (swz % 64) / 2; }
__device__ __forceinline__ int perm32(int rho) { const int n = rho >> 4, i = rho & 15; return 8 * (i >> 2) + 4 * n + (i & 3); }

struct GUnit { const char* A; const char* B; unsigned rsB; int pm, pn, tr; };
__device__ __forceinline__ void vt_tile_tokens(int layer, int j, int pm, int& tok0, int& dil) {
    dil = 1; tok0 = 256 * pm;
    if (layer == 1) { const int sh = 2 * (j >> 2); dil = 1 << sh; const int L = SEQ >> sh; tok0 = ((256 * pm) % L) * dil + (256 * pm) / L; }
}

__device__ __forceinline__ bool tile_order(int i, int G, int c, int nM, int nN, int& pm, int& pn) {
    const int nwg = nM * nN; const long L = (long)i * G + c; if (L >= nwg) return false;
    int wgid = (int)L; { const int q = nwg / NXCD, r = nwg % NXCD, xcd = wgid % NXCD, off = wgid / NXCD; wgid = (xcd < r ? xcd * (q + 1) : r * (q + 1) + (xcd - r) * q) + off; }
    const int nig = WGM * nN, gid = wgid / nig, fm = gid * WGM, gsz = (nM - fm) < WGM ? (nM - fm) : WGM;
    pm = fm + ((wgid % nig) % gsz); pn = (wgid % nig) / gsz; return true;
}

struct ProjSched {
    int nM, nN, nNorm, G, c, layer; const char* X; const char* W; int vrow0;
    __device__ __forceinline__ bool next(int i, GUnit& u) const {
        int pm, pn; if (!tile_order(i, G, c, nM, nN, pm, pn)) return false;
        u.pm = pm; u.pn = pn;
        if (pn < nNorm) { u.tr = 0; u.A = X + (size_t)pm * 256 * KDIM * 2; u.B = W + (size_t)pn * 256 * KDIM * 2; u.rsB = KDIM * 2; }
        else {
            const int j = pn - nNorm; u.tr = 1; u.A = W + (size_t)(vrow0 + 256 * j) * KDIM * 2;
            int tok0, dil; vt_tile_tokens(layer, j, pm, tok0, dil);
            u.B = X + (size_t)tok0 * KDIM * 2; u.rsB = (unsigned)dil * KDIM * 2;
        }
        return true;
    }
};
struct OutSched {
    int nM, nN, G, c; const char* A0; const char* A1; int split_pm; const char* W;
    __device__ __forceinline__ bool next(int i, GUnit& u) const {
        int pm, pn; if (!tile_order(i, G, c, nM, nN, pm, pn)) return false;
        u.pm = pm; u.pn = pn; u.tr = 0; u.rsB = KDIM * 2;
        u.A = (pm < split_pm) ? A0 + (size_t)pm * 256 * KDIM * 2 : A1 + (size_t)(pm - split_pm) * 256 * KDIM * 2;
        u.B = W + (size_t)pn * 256 * KDIM * 2; return true;
    }
};

struct EpiProj {
    bf16* QKG; int ldq; int nNorm; bf16* VT; int ldv; const float* ss; int tok_base; int layer;
    __device__ __forceinline__ void prep(const GUnit& u, int wr, int wc, int fr, int fq, float (&cs)[2][8]) const {
#pragma unroll
        for (int a = 0; a < 2; ++a)
#pragma unroll
            for (int e = 0; e < 8; ++e) cs[a][e] = 1.0f;
        if (ss) {
            int tok[2][8]; int tok0, dil; vt_tile_tokens(layer, u.pn - nNorm, u.pm, tok0, dil);
#pragma unroll
            for (int a = 0; a < 2; ++a)
#pragma unroll
                for (int e = 0; e < 8; ++e)
                    tok[a][e] = u.tr ? tok_base + tok0 + (a * HALF + wc * 32 + 8 * fq + e) * dil : tok_base + u.pm * 256 + a * HALF + wr * 64 + (e & 3) * 16 + fr;
            float s[2][8];
#pragma unroll
            for (int a = 0; a < 2; ++a)
#pragma unroll
                for (int e = 0; e < 8; ++e) s[a][e] = 0.f;
#pragma unroll 1
            for (int p = 0; p < 16; ++p) {
#pragma unroll
                for (int a = 0; a < 2; ++a)
#pragma unroll
                    for (int e = 0; e < 8; ++e) s[a][e] += ss[p * M + tok[a][e]];
            }
#pragma unroll
            for (int a = 0; a < 2; ++a)
#pragma unroll
                for (int e = 0; e < 8; ++e) cs[a][e] = __builtin_amdgcn_rsqf(s[a][e] * (1.0f / D) + RMS_EPS);
        }
    }
    __device__ __forceinline__ void rowgroup(const f32x4 (&a)[2][2], const GUnit& u, int ai, int m, int wr, int wc, int fr, int fq, const float (&cs)[2][8]) const {
        if (!u.tr) {
            const int row = u.pm * 256 + ai * HALF + wr * 64 + m * 16 + fr;
            const float sc = cs[ai][m];
            bf16* rowp = QKG + (size_t)row * ldq + u.pn * 256 + wc * 32 + 8 * fq;
#pragma unroll
            for (int bj = 0; bj < 2; ++bj) { const f32x4 v0 = a[bj][0] * sc, v1 = a[bj][1] * sc;
                v4u w; w.x = cvt_pk_bf16(v0[0], v0[1]); w.y = cvt_pk_bf16(v0[2], v0[3]); w.z = cvt_pk_bf16(v1[0], v1[1]); w.w = cvt_pk_bf16(v1[2], v1[3]);
                *(v4u*)(rowp + bj * HALF) = w; }
        } else {
            const int j = u.pn - nNorm, g = j >> 2, fb = j & 3;
            const int frow = g * 1024 + fb * 256 + ai * HALF + wr * 64 + m * 16 + fr;
            bf16* rowp = VT + (size_t)frow * ldv + u.pm * 256 + wc * 32 + 8 * fq;
#pragma unroll
            for (int bj = 0; bj < 2; ++bj) { const f32x4 v0 = a[bj][0], v1 = a[bj][1];
                v4u w; w.x = cvt_pk_bf16(v0[0] * cs[bj][0], v0[1] * cs[bj][1]); w.y = cvt_pk_bf16(v0[2] * cs[bj][2], v0[3] * cs[bj][3]);
                w.z = cvt_pk_bf16(v1[0] * cs[bj][4], v1[1] * cs[bj][5]); w.w = cvt_pk_bf16(v1[2] * cs[bj][6], v1[3] * cs[bj][7]);
                *(v4u*)(rowp + bj * HALF) = w; }
        }
    }
};
struct EpiRes {
    const float* resid; float* out; bf16* xb; float* ss;
    __device__ __forceinline__ void prep(const GUnit&, int, int, int, int, float (&cs)[2][8]) const {
#pragma unroll
        for (int bj = 0; bj < 2; ++bj)
#pragma unroll
            for (int e = 0; e < 8; ++e) cs[bj][e] = 1.0f;
    }
    __device__ __forceinline__ void rowgroup(const f32x4 (&a)[2][2], const GUnit& u, int ai, int m, int wr, int wc, int fr, int fq, const float (&)[2][8]) const {
        const int row = u.pm * 256 + ai * HALF + wr * 64 + m * 16 + fr;
        const size_t off = (size_t)row * D + u.pn * 256 + wc * 32 + 8 * fq;
        float q = 0.f;
#pragma unroll
        for (int bj = 0; bj < 2; ++bj) {
            const f32x4 r0 = *(const f32x4*)(resid + off + bj * HALF), r1 = *(const f32x4*)(resid + off + bj * HALF + 4);
            const f32x4 v0 = a[bj][0] + r0, v1 = a[bj][1] + r1;
            *(f32x4*)(out + off + bj * HALF) = v0; *(f32x4*)(out + off + bj * HALF + 4) = v1;
            q += (v0[0] * v0[0] + v0[1] * v0[1]) + (v0[2] * v0[2] + v0[3] * v0[3]) + (v1[0] * v1[0] + v1[1] * v1[1]) + (v1[2] * v1[2] + v1[3] * v1[3]);
            if (xb) { v4u w; w.x = cvt_pk_bf16(v0[0], v0[1]); w.y = cvt_pk_bf16(v0[2], v0[3]); w.z = cvt_pk_bf16(v1[0], v1[1]); w.w = cvt_pk_bf16(v1[2], v1[3]);
                *(v4u*)(xb + off + bj * HALF) = w; }
        }
        q += __shfl_xor(q, 16); q += __shfl_xor(q, 32);
        if (fq == 0) ss[(size_t)(u.pn * 4 + wc) * M + row] = q;
    }
};
template <class Epi>
__device__ __forceinline__ void epi_tile(const Epi& E, const f32x4 (&acc)[2][2][4][2], const GUnit& u, int wr, int wc, int fr, int fq) {
    float cs[2][8]; E.prep(u, wr, wc, fr, fq, cs);
#pragma unroll
    for (int ai = 0; ai < 2; ++ai)
#pragma unroll
        for (int m = 0; m < 4; ++m) { const f32x4 a[2][2] = {{acc[ai][0][m][0], acc[ai][0][m][1]}, {acc[ai][1][m][0], acc[ai][1][m][1]}}; E.rowgroup(a, u, ai, m, wr, wc, fr, fq, cs); }
}

#if FAST_GEMM
template <class Epi, class Sched, bool ALIGN_EPI>
__device__ __forceinline__ void gemm_phase(LAS unsigned char* lds, const Sched& S, const Epi& E) {
    int tid_ = threadIdx.x; asm volatile("" : "+v"(tid_));
    const int tid = tid_, wid = __builtin_amdgcn_readfirstlane(tid >> 6), lane = tid & 63, wr = wid >> 2, wc = wid & 3, fr = lane & 15, fq = lane >> 4;
    constexpr int nt = KDIM / BK;
    unsigned vA[2], RB[2], CC[2];
#pragma unroll
    for (int i = 0; i < 2; ++i) { int R, C; stage_rc(tid * 16 + i * 8192, R, C); vA[i] = (unsigned)(R * KDIM + C) * 2u; RB[i] = (unsigned)((R & ~31) + perm32(R & 31)); CC[i] = (unsigned)C * 2u; }
    constexpr size_t hA = (size_t)HALF * KDIM * 2;
    const size_t kstep = (size_t)(BK * 2);
    const unsigned ldsw = (unsigned)wid * 1024u;
    const int aoff = lds_byte(wr * 64 + fr, fq * 8), boff = lds_byte(wc * 32 + fr, fq * 8);
#define PG8_SA(b, h) (((b) * 2 + (h)) * HTB)
#define PG8_SB(b, h) ((4 + (b) * 2 + (h)) * HTB)
#define PG8_STAGE(bufoff, gbase, voff) do { _Pragma("unroll") for (int _i = 0; _i < 2; ++_i) \
        __builtin_amdgcn_global_load_lds((const unsigned*)((const char*)(gbase) + (voff)[_i]), (LAS unsigned*)(lds + (bufoff) + ldsw + _i * 8192), 16, 0, 0); } while (0)
#define PG8_STAGEB(bufoff, gbase, rs) do { _Pragma("unroll") for (int _i = 0; _i < 2; ++_i) \
        __builtin_amdgcn_global_load_lds((const unsigned*)((const char*)(gbase) + (RB[_i] * (rs) + CC[_i])), (LAS unsigned*)(lds + (bufoff) + ldsw + _i * 8192), 16, 0, 0); } while (0)
#define PG8_LDA(dst, b, h) do { _Pragma("unroll") for (int m = 0; m < 4; ++m) _Pragma("unroll") for (int k = 0; k < 2; ++k) dst[m][k] = *(const LAS bf16x8*)(lds + PG8_SA(b, h) + aoff + m * 2048 + k * 1024); } while (0)
#define PG8_LDB(dst, b, h) do { _Pragma("unroll") for (int n = 0; n < 2; ++n) _Pragma("unroll") for (int k = 0; k < 2; ++k) dst[n][k] = *(const LAS bf16x8*)(lds + PG8_SB(b, h) + boff + n * 2048 + k * 1024); } while (0)
#define PG8_MMA(ai, bj, At, Bt) do { __builtin_amdgcn_s_setprio(1); _Pragma("unroll") for (int m = 0; m < 4; ++m) _Pragma("unroll") for (int n = 0; n < 2; ++n) _Pragma("unroll") for (int k = 0; k < 2; ++k) \
        acc[ai][bj][m][n] = __builtin_amdgcn_mfma_f32_16x16x32_bf16(Bt[n][k], At[m][k], acc[ai][bj][m][n], 0, 0, 0); __builtin_amdgcn_s_setprio(0); } while (0)
#define PG8_WAIT_V(n) asm volatile("s_waitcnt vmcnt(" #n ")" ::: "memory")
#define PG8_WAIT_L(n) asm volatile("s_waitcnt lgkmcnt(" #n ")" ::: "memory")
#define PG8_BAR __builtin_amdgcn_s_barrier()
#define PG8_SCHED __builtin_amdgcn_sched_barrier(0)
    GUnit cur, nxt; int ui = 0;
    if (!S.next(0, cur)) return;
    f32x4 acc[2][2][4][2];
#pragma unroll
    for (int a = 0; a < 2; ++a)
#pragma unroll
        for (int b = 0; b < 2; ++b)
#pragma unroll
            for (int m = 0; m < 4; ++m)
#pragma unroll
                for (int n = 0; n < 2; ++n) acc[a][b][m][n] = (f32x4){0.f, 0.f, 0.f, 0.f};
    bf16x8 At[4][2], B0[2][2], B1[2][2];
    const char* cA = cur.A; const char* cB = cur.B;
    unsigned rB = cur.rsB; size_t hB = (size_t)HALF * cur.rsB;
    PG8_STAGEB(PG8_SB(0, 0), cB, rB); PG8_STAGEB(PG8_SB(0, 1), cB + hB, rB); PG8_STAGE(PG8_SA(0, 0), cA, vA); PG8_STAGE(PG8_SA(0, 1), cA + hA, vA);
    if (wr == 1) PG8_BAR;
    PG8_WAIT_V(2); PG8_BAR;
    PG8_STAGEB(PG8_SB(1, 0), cB + kstep, rB); PG8_STAGE(PG8_SA(1, 0), cA + kstep, vA); PG8_STAGEB(PG8_SB(1, 1), cB + hB + kstep, rB);
    PG8_WAIT_V(6); PG8_BAR;
    for (;;) {
        const bool has_next = S.next(ui + 1, nxt);
        const char* nA = has_next ? nxt.A : cA; const char* nB = has_next ? nxt.B : cB;
        const unsigned nrB = has_next ? nxt.rsB : rB; const size_t nhB = (size_t)HALF * nrB;
        for (int t = 0; t < nt; t += 2) {
            const bool last = (t == nt - 2);
            const char* a1 = cA + (size_t)(t + 1) * kstep;
            const char* a2 = last ? nA : cA + (size_t)(t + 2) * kstep; const char* b2 = last ? nB : cB + (size_t)(t + 2) * kstep;
            const char* a3 = a2 + kstep; const char* b3 = b2 + kstep;
            const unsigned wrB = last ? nrB : rB; const size_t gB = last ? nhB : hB;
            PG8_LDB(B0, 0, 0); PG8_LDB(B1, 0, 1); PG8_SCHED; PG8_LDA(At, 0, 0); PG8_STAGE(PG8_SA(1, 1), a1 + hA, vA);
            PG8_WAIT_V(8); PG8_WAIT_L(0); PG8_BAR; PG8_MMA(0, 0, At, B0); PG8_MMA(0, 1, At, B1); PG8_BAR; PG8_SCHED;
            PG8_LDA(At, 0, 1); PG8_STAGEB(PG8_SB(0, 0), b2, wrB); PG8_STAGEB(PG8_SB(0, 1), b2 + gB, wrB); PG8_STAGE(PG8_SA(0, 0), a2, vA);
            PG8_WAIT_V(8); PG8_WAIT_L(0); PG8_BAR; PG8_MMA(1, 0, At, B0); PG8_MMA(1, 1, At, B1); PG8_BAR; PG8_SCHED;
            PG8_LDB(B0, 1, 0); PG8_LDB(B1, 1, 1); PG8_SCHED; PG8_LDA(At, 1, 0); PG8_STAGE(PG8_SA(0, 1), a2 + hA, vA);
            PG8_WAIT_V(8); PG8_WAIT_L(0); PG8_BAR; PG8_MMA(0, 0, At, B0); PG8_MMA(0, 1, At, B1); PG8_BAR; PG8_SCHED;
            PG8_LDA(At, 1, 1); PG8_STAGEB(PG8_SB(1, 0), b3, wrB); PG8_STAGEB(PG8_SB(1, 1), b3 + gB, wrB); PG8_STAGE(PG8_SA(1, 0), a3, vA);
            PG8_WAIT_V(8); PG8_WAIT_L(0); PG8_BAR; PG8_MMA(1, 0, At, B0); PG8_MMA(1, 1, At, B1); PG8_BAR; PG8_SCHED;
        }
        if constexpr (ALIGN_EPI) { if (wr == 0) PG8_BAR; }
        epi_tile(E, acc, cur, wr, wc, fr, fq);
        if (!has_next) break;
#pragma unroll
        for (int a = 0; a < 2; ++a)
#pragma unroll
            for (int b = 0; b < 2; ++b)
#pragma unroll
                for (int m = 0; m < 4; ++m)
#pragma unroll
                    for (int n = 0; n < 2; ++n) acc[a][b][m][n] = (f32x4){0.f, 0.f, 0.f, 0.f};
        cur = nxt; cA = nA; cB = nB; rB = nrB; hB = nhB; ++ui;
        if constexpr (ALIGN_EPI) { if (wr == 1) PG8_BAR; }
    }
    PG8_WAIT_V(0);
    if constexpr (!ALIGN_EPI) { if (wr == 0) PG8_BAR; }
    PG8_BAR;
#undef PG8_SA
#undef PG8_SB
#undef PG8_STAGE
#undef PG8_STAGEB
#undef PG8_LDA
#undef PG8_LDB
#undef PG8_MMA
#undef PG8_WAIT_V
#undef PG8_WAIT_L
#undef PG8_BAR
#undef PG8_SCHED
}
#else
__device__ __forceinline__ float dot8(const v4u a, const v4u b) {
    return (bflo(a.x) * bflo(b.x) + bfhi(a.x) * bfhi(b.x)) + (bflo(a.y) * bflo(b.y) + bfhi(a.y) * bfhi(b.y)) + (bflo(a.z) * bflo(b.z) + bfhi(a.z) * bfhi(b.z)) + (bflo(a.w) * bflo(b.w) + bfhi(a.w) * bfhi(b.w));
}
template <class Epi, class Sched, bool ALIGN_EPI>
__device__ __forceinline__ void gemm_phase(LAS unsigned char* lds, const Sched& S, const Epi& E) {
    const int tid = threadIdx.x, wid = __builtin_amdgcn_readfirstlane(tid >> 6), lane = tid & 63, wr = wid >> 2, wc = wid & 3, fr = lane & 15, fq = lane >> 4;
    GUnit cur;
    for (int ui = 0; S.next(ui, cur); ++ui) {
        float cs[2][8]; E.prep(cur, wr, wc, fr, fq, cs);
#pragma unroll
        for (int am = 0; am < 8; ++am) {
            const int ai = am >> 2, m = am & 3;
            const char* ap = cur.A + (size_t)(ai * HALF + wr * 64 + m * 16 + fr) * (KDIM * 2);
            const char* bp = cur.B + (size_t)(wc * 32 + 8 * fq) * cur.rsB;
            float s[2][8];
#pragma unroll
            for (int bj = 0; bj < 2; ++bj)
#pragma unroll
                for (int e = 0; e < 8; ++e) s[bj][e] = 0.f;
#pragma unroll 1
            for (int k8 = 0; k8 < KDIM / 8; ++k8) {
                const v4u av = *(const v4u*)(ap + 16 * k8);
#pragma unroll
                for (int bj = 0; bj < 2; ++bj)
#pragma unroll
                    for (int e = 0; e < 8; ++e) s[bj][e] += dot8(av, *(const v4u*)(bp + (size_t)(bj * HALF + e) * cur.rsB + 16 * k8));
            }
            const f32x4 a[2][2] = {{(f32x4){s[0][0], s[0][1], s[0][2], s[0][3]}, (f32x4){s[0][4], s[0][5], s[0][6], s[0][7]}}, {(f32x4){s[1][0], s[1][1], s[1][2], s[1][3]}, (f32x4){s[1][4], s[1][5], s[1][6], s[1][7]}}};
            E.rowgroup(a, cur, ai, m, wr, wc, fr, fq, cs);
        }
    }
}
#endif

struct Frame {
    LAS unsigned char* lds;
    int tid, lane, wave, vcu, G;
    const float *x, *g0, *w_in0, *rpb, *w_out0, *g1, *w_in1, *w_out1, *gf;
    float* out; unsigned char* ws;
};

__device__ __forceinline__ void p0_transpose_item(const float* W, int N, bf16* WT, int dst0, int src0, int kb, float sc, const float* gk, LAS float* scr, int lane) {
    const int k0 = 64 * kb;
#pragma unroll 8
    for (int i = 0; i < 32; ++i) { const int kk = 2 * i + (lane >> 5); float w = W[(size_t)(k0 + kk) * N + src0 + (lane & 31)] * sc; if (gk) w *= gk[k0 + kk]; scr[kk * 33 + (lane & 31)] = w; }
    LDS_WAIT(); asm volatile("" ::: "memory");
    const int c = lane & 7;
#pragma unroll
    for (int j = 0; j < 4; ++j) { const int n = (lane >> 3) + 8 * j; const LAS float* s = scr + (8 * c) * 33 + n;
        v4u o; o.x = pk2(s[0 * 33], s[1 * 33]); o.y = pk2(s[2 * 33], s[3 * 33]); o.z = pk2(s[4 * 33], s[5 * 33]); o.w = pk2(s[6 * 33], s[7 * 33]);
        *(v4u*)(WT + (size_t)(dst0 + n) * KDIM + k0 + 8 * c) = o; }
    LDS_WAIT(); asm volatile("" ::: "memory");
}
__device__ __forceinline__ void p0_prologue(Frame& F) {
    LAS float* scr = (LAS float*)(F.lds + F.wave * 16384);
    const int gw = F.vcu * NWAVES + F.wave, NGW = F.G * NWAVES;
    bf16* WT0 = (bf16*)(F.ws + WS_WT0); bf16* WO0 = (bf16*)(F.ws + WS_WO0); bf16* WT1 = (bf16*)(F.ws + WS_WT1); bf16* WO1 = (bf16*)(F.ws + WS_WO1);
    constexpr int I0 = 128 * 16, I1 = 32 * 16, I2 = 320 * 16, I3 = 32 * 16, NIT = I0 + I1 + I2 + I3;
    for (int it = gw; it < NIT; it += NGW) {
        int r = it;
        if (r < I0) { const int rb = r >> 4, kb = r & 15, d0 = 32 * rb, sec = d0 >> 10, within = d0 & 1023;
            const int srcsec = (sec == 0) ? 0 : (sec == 1) ? 1024 : (sec == 2) ? 3072 : 2048;
            p0_transpose_item(F.w_in0, N0, WT0, d0, srcsec + within, kb, sec == 0 ? QSCALE : 1.0f, nullptr, scr, F.lane); continue; }
        r -= I0;
        if (r < I1) { const int rb = r >> 4, kb = r & 15; p0_transpose_item(F.w_out0, D, WO0, 32 * rb, 32 * rb, kb, 1.0f, nullptr, scr, F.lane); continue; }
        r -= I1;
        if (r < I2) { const int rb = r >> 4, kb = r & 15, d0 = 32 * rb, sec = d0 >> 10, within = d0 & 1023;
            int srcsec; if (sec < 6) srcsec = (sec >> 1) * 3072 + (sec & 1) * 1024; else if (sec == 6) srcsec = 9216; else srcsec = (sec - 7) * 3072 + 2048;
            p0_transpose_item(F.w_in1, N1, WT1, d0, srcsec + within, kb, (sec < 6 && !(sec & 1)) ? QSCALE : 1.0f, F.g1, scr, F.lane); continue; }
        r -= I2;
        { const int rb = r >> 4, kb = r & 15; p0_transpose_item(F.w_out1, D, WO1, 32 * rb, 32 * rb, kb, 1.0f, nullptr, scr, F.lane); }
    }
    bf16* XB = (bf16*)(F.ws + WS_XB);
    for (int m = gw; m < M; m += NGW) {
        const f32x4* xr = (const f32x4*)(F.x + (size_t)m * D) + F.lane; const f32x4* gr = (const f32x4*)F.g0 + F.lane;
        f32x4 v[4]; float s = 0.f;
#pragma unroll
        for (int j = 0; j < 4; ++j) { v[j] = xr[64 * j]; s += (v[j].x * v[j].x + v[j].y * v[j].y) + (v[j].z * v[j].z + v[j].w * v[j].w); }
        const float rstd = __builtin_amdgcn_rsqf(wave_sum(s) * (1.0f / D) + RMS_EPS);
        unsigned long long* o8 = (unsigned long long*)(XB + (size_t)m * D) + F.lane;
#pragma unroll
        for (int j = 0; j < 4; ++j) { const f32x4 g = gr[64 * j];
            o8[64 * j] = (unsigned long long)pk2(v[j].x * rstd * g.x, v[j].y * rstd * g.y) | ((unsigned long long)pk2(v[j].z * rstd * g.z, v[j].w * rstd * g.w) << 32); }
    }
}

#if FAST_ATTN_A
__device__ __forceinline__ void attn_a_phase(Frame& F) {
    int tid_ = threadIdx.x; asm volatile("" : "+v"(tid_));
    const int lane = tid_ & 63, wave = __builtin_amdgcn_readfirstlane(tid_ >> 6), q = lane & 15, g = lane >> 4;
    const bf16* QKG = (const bf16*)(F.ws + WS_QKG0); const bf16* VT = (const bf16*)(F.ws + WS_VT0); bf16* OG = (bf16*)(F.ws + WS_OG0);
    const int pair = F.vcu >> 3, strip = F.vcu & 7, b = pair >> 4, h = pair & 15;
    LAS float* rpbL = (LAS float*)F.lds;
    for (int i = tid_; i < 15 * 31; i += NWAVES * 64) rpbL[i] = F.rpb[h * 15 * 31 + i] * LOG2E;
    __syncthreads();
    const int drow = 16 * (q >> 2) + (q & 3);
    const int kap = 8 * (q >> 2) + (q & 3);
    for (int it = 0; it < 8; ++it) {
        const int e = wave + 8 * it, row = strip * 16 + (e >> 2), blk = e & 3;
        const int rs = min(max(row - 4, 0), 120), kb = min(max(blk * 16 - 8, 0), 32);
        const size_t tokq = (size_t)b * SEQ + row * 64 + blk * 16 + q;
        const bf16* qp = QKG + tokq * LDQ0 + h * 64 + 16 * g;
        const bf16x8 q0 = *(const bf16x8*)qp, q1 = *(const bf16x8*)(qp + 8);
        f32x4 S[8][2];
#pragma unroll
        for (int u = 0; u < 8; ++u)
#pragma unroll
            for (int hf = 0; hf < 2; ++hf) {
                const size_t ktok = (size_t)b * SEQ + (rs + u) * 64 + kb + kap + 4 * hf;
                const bf16* kp = QKG + ktok * LDQ0 + 1024 + h * 64 + 16 * g;
                const bf16x8 k0 = *(const bf16x8*)kp, k1 = *(const bf16x8*)(kp + 8);
                f32x4 s = __builtin_amdgcn_mfma_f32_16x16x32_bf16(k0, q0, (f32x4){0.f, 0.f, 0.f, 0.f}, 0, 0, 0);
                S[u][hf] = __builtin_amdgcn_mfma_f32_16x16x32_bf16(k1, q1, s, 0, 0, 0);
            }
        const int qcol = blk * 16 + q, cst = min(max(qcol - 8, 0), 48);
        int coff[2][4]; bool val[2][4];
#pragma unroll
        for (int hf = 0; hf < 2; ++hf)
#pragma unroll
            for (int j = 0; j < 4; ++j) { const int kc = kb + 8 * g + 4 * hf + j; val[hf][j] = (kc >= cst) && (kc < cst + 16); coff[hf][j] = min(max(kc - qcol + 15, 0), 30); }
        float mx = -1e30f;
#pragma unroll
        for (int u = 0; u < 8; ++u) {
            const LAS float* br = rpbL + (rs + u - row + 7) * 31;
#pragma unroll
            for (int hf = 0; hf < 2; ++hf)
#pragma unroll
                for (int j = 0; j < 4; ++j) { const float s = val[hf][j] ? S[u][hf][j] + br[coff[hf][j]] : -1e30f; S[u][hf][j] = s; mx = fmaxf(mx, s); }
        }
        mx = fmaxf(mx, __shfl_xor(mx, 16)); mx = fmaxf(mx, __shfl_xor(mx, 32));
        float ls = 0.f; bf16x8 pb[8];
#pragma unroll
        for (int u = 0; u < 8; ++u) {
            float p[8];
#pragma unroll
            for (int hf = 0; hf < 2; ++hf)
#pragma unroll
                for (int j = 0; j < 4; ++j) { p[4 * hf + j] = fast_exp2(S[u][hf][j] - mx); ls += p[4 * hf + j]; }
            v4u w; w.x = cvt_pk_bf16(p[0], p[1]); w.y = cvt_pk_bf16(p[2], p[3]); w.z = cvt_pk_bf16(p[4], p[5]); w.w = cvt_pk_bf16(p[6], p[7]);
            pb[u] = __builtin_bit_cast(bf16x8, w);
        }
        ls += __shfl_xor(ls, 16); ls += __shfl_xor(ls, 32);
        f32x4 O[4];
#pragma unroll
        for (int dt = 0; dt < 4; ++dt) O[dt] = (f32x4){0.f, 0.f, 0.f, 0.f};
#pragma unroll
        for (int u = 0; u < 8; ++u) {
            const size_t pos0 = (size_t)b * SEQ + (rs + u) * 64 + kb + 8 * g;
#pragma unroll
            for (int dt = 0; dt < 4; ++dt) {
                const bf16x8 vf = *(const bf16x8*)(VT + (size_t)(h * 64 + drow + 4 * dt) * M + pos0);
                O[dt] = __builtin_amdgcn_mfma_f32_16x16x32_bf16(vf, pb[u], O[dt], 0, 0, 0);
            }
        }
        const float inv = __builtin_amdgcn_rcpf(ls);
        const bf16* gp = QKG + tokq * LDQ0 + 2048 + h * 64 + 16 * g;
        const v4u g0 = *(const v4u*)gp, g1 = *(const v4u*)(gp + 8);
        const unsigned gw[8] = {g0.x, g0.y, g0.z, g0.w, g1.x, g1.y, g1.z, g1.w};
        unsigned ow[8];
#pragma unroll
        for (int dt = 0; dt < 4; ++dt) {
            const float a0 = O[dt][0] * inv * silu_f(bflo(gw[2 * dt])), a1 = O[dt][1] * inv * silu_f(bfhi(gw[2 * dt]));
            const float a2 = O[dt][2] * inv * silu_f(bflo(gw[2 * dt + 1])), a3 = O[dt][3] * inv * silu_f(bfhi(gw[2 * dt + 1]));
            ow[2 * dt] = cvt_pk_bf16(a0, a1); ow[2 * dt + 1] = cvt_pk_bf16(a2, a3);
        }
        bf16* op = OG + tokq * D + h * 64 + 16 * g;
        *(v4u*)op = (v4u){ow[0], ow[1], ow[2], ow[3]}; *(v4u*)(op + 8) = (v4u){ow[4], ow[5], ow[6], ow[7]};
    }
}
#else
__device__ __forceinline__ void attn_a_phase(Frame& F) {
    const bf16* QKG = (const bf16*)(F.ws + WS_QKG0); const bf16* VT = (const bf16*)(F.ws + WS_VT0); bf16* OG = (bf16*)(F.ws + WS_OG0);
    const int gw = F.vcu * NWAVES + F.wave, NGW = F.G * NWAVES, lane = F.lane;
    for (int it = gw; it < M * H; it += NGW) {
        const int tok = it >> 4, h = it & 15, b = tok >> 13, t = tok & 8191, r = t >> 6, c = t & 63;
        const int rs = min(max(r - 4, 0), 120), cs = min(max(c - 8, 0), 48);
        const float qd = bf2f(QKG[(size_t)tok * LDQ0 + h * 64 + lane]);
        float m = -1e30f, l = 0.f, o = 0.f;
        for (int kr = 0; kr < 8; ++kr)
            for (int kc = 0; kc < 16; ++kc) {
                const int ktok = (b << 13) + (rs + kr) * 64 + cs + kc;
                const float s = wave_sum(qd * bf2f(QKG[(size_t)ktok * LDQ0 + 1024 + h * 64 + lane])) + F.rpb[(h * 15 + (rs + kr - r + 7)) * 31 + (cs + kc - c + 15)] * LOG2E;
                const float mn = fmaxf(m, s), al = fast_exp2(m - mn), p = fast_exp2(s - mn);
                l = l * al + p; o = o * al + p * bf2f(VT[(size_t)(h * 64 + lane) * M + ktok]); m = mn;
            }
        const float g = bf2f(QKG[(size_t)tok * LDQ0 + 2048 + h * 64 + lane]);
        OG[(size_t)tok * D + h * 64 + lane] = (bf16)f2bf(o / l * silu_f(g));
    }
}
#endif

#if FAST_ATTN_B
__device__ __forceinline__ int ox_off(int g, int tlb, int c) { const int f = ((tlb & 7) + ((tlb >> 3) & 7) + ((tlb >> 6) & 7)) & 7; return g * 65536 + tlb * 128 + ((c ^ f) << 4); }
__device__ __forceinline__ void attn_b_phase(Frame& F, int b) {
    int tid_ = threadIdx.x; asm volatile("" : "+v"(tid_));
    const int lane = tid_ & 63, wave = __builtin_amdgcn_readfirstlane(tid_ >> 6), q = lane & 15, g4 = lane >> 4;
    const bf16* QKG = (const bf16*)(F.ws + WS_QKG1); const bf16* VT = (const bf16*)(F.ws + WS_VT1); bf16* OG = (bf16*)(F.ws + (b == 0 ? WS_OG1A : WS_OG1B));
    const int h = F.vcu >> 4, blk = F.vcu & 15;
    const float slope2 = exp2f(-0.5f * (float)(h + 1)) * LOG2E;
    LAS unsigned char* OX = F.lds; LAS float* LSE = (LAS float*)(F.lds + LSE_OFF);
    const int drow = 16 * (q >> 2) + (q & 3), kap = 8 * (q >> 2) + (q & 3);
#pragma unroll 1
    for (int grp = 0; grp < 3; ++grp) {
        if (grp == 2) __syncthreads();
        const int sh = 2 * grp, dil = 1 << sh, L = SEQ >> sh, npr = 512 >> sh, upr = npr >> 5;
        const bf16* Qg = QKG + grp * 2048 + h * 64; const bf16* Kg = Qg + 1024;
        const bf16* Vg = VT + (size_t)(grp * 1024 + h * 64) * SEQ;
#pragma unroll 1
        for (int it = 0; it < 2; ++it) {
            const int un = wave + 8 * it, rr = un / upr, i0 = npr * blk + 32 * (un % upr);
            bf16x8 qf[2][2];
#pragma unroll
            for (int qt = 0; qt < 2; ++qt) { const bf16* qp = Qg + (size_t)((i0 + 16 * qt + q) * dil + rr) * LDQ1 + 16 * g4; qf[qt][0] = *(const bf16x8*)qp; qf[qt][1] = *(const bf16x8*)(qp + 8); }
            f32x4 S[2][5][2];
#pragma unroll
            for (int ks = 0; ks < 5; ++ks) {
                const int p0 = i0 - 64 + 32 * ks;
                if (p0 >= 0 && p0 < L) {
#pragma unroll
                    for (int hf = 0; hf < 2; ++hf) {
                        const bf16* kp = Kg + (size_t)((p0 + kap + 4 * hf) * dil + rr) * LDQ1 + 16 * g4;
                        const bf16x8 k0 = *(const bf16x8*)kp, k1 = *(const bf16x8*)(kp + 8);
#pragma unroll
                        for (int qt = 0; qt < 2; ++qt) {
                            f32x4 s = __builtin_amdgcn_mfma_f32_16x16x32_bf16(k0, qf[qt][0], (f32x4){0.f, 0.f, 0.f, 0.f}, 0, 0, 0);
                            s = __builtin_amdgcn_mfma_f32_16x16x32_bf16(k1, qf[qt][1], s, 0, 0, 0);
#pragma unroll
                            for (int j = 0; j < 4; ++j) { const int dj = (p0 + 8 * g4 + 4 * hf + j) - (i0 + 16 * qt + q); const int ad = dj < 0 ? -dj : dj;
                                s[j] = (ad <= 64) ? s[j] - slope2 * (float)(ad * dil) : -1e30f; }
                            S[qt][ks][hf] = s;
                        }
                    }
                } else {
#pragma unroll
                    for (int hf = 0; hf < 2; ++hf)
#pragma unroll
                        for (int qt = 0; qt < 2; ++qt) S[qt][ks][hf] = (f32x4){-1e30f, -1e30f, -1e30f, -1e30f};
                }
            }
            float mx[2], ls[2]; bf16x8 pb[2][5];
#pragma unroll
            for (int qt = 0; qt < 2; ++qt) {
                float m = -1e30f;
#pragma unroll
                for (int ks = 0; ks < 5; ++ks)
#pragma unroll
                    for (int hf = 0; hf < 2; ++hf)
#pragma unroll
                        for (int j = 0; j < 4; ++j) m = fmaxf(m, S[qt][ks][hf][j]);
                m = fmaxf(m, __shfl_xor(m, 16)); m = fmaxf(m, __shfl_xor(m, 32));
                float l = 0.f;
#pragma unroll
                for (int ks = 0; ks < 5; ++ks) {
                    float p[8];
#pragma unroll
                    for (int hf = 0; hf < 2; ++hf)
#pragma unroll
                        for (int j = 0; j < 4; ++j) { p[4 * hf + j] = fast_exp2(S[qt][ks][hf][j] - m); l += p[4 * hf + j]; }
                    v4u w; w.x = cvt_pk_bf16(p[0], p[1]); w.y = cvt_pk_bf16(p[2], p[3]); w.z = cvt_pk_bf16(p[4], p[5]); w.w = cvt_pk_bf16(p[6], p[7]);
                    pb[qt][ks] = __builtin_bit_cast(bf16x8, w);
                }
                l += __shfl_xor(l, 16); l += __shfl_xor(l, 32);
                mx[qt] = m; ls[qt] = l;
            }
            f32x4 O[2][4];
#pragma unroll
            for (int qt = 0; qt < 2; ++qt)
#pragma unroll
                for (int dt = 0; dt < 4; ++dt) O[qt][dt] = (f32x4){0.f, 0.f, 0.f, 0.f};
#pragma unroll
            for (int ks = 0; ks < 5; ++ks) {
                const int p0 = i0 - 64 + 32 * ks;
                if (p0 >= 0 && p0 < L) {
#pragma unroll
                    for (int dt = 0; dt < 4; ++dt) {
                        const bf16x8 vf = *(const bf16x8*)(Vg + (size_t)(drow + 4 * dt) * SEQ + rr * L + p0 + 8 * g4);
#pragma unroll
                        for (int qt = 0; qt < 2; ++qt) O[qt][dt] = __builtin_amdgcn_mfma_f32_16x16x32_bf16(vf, pb[qt][ks], O[qt][dt], 0, 0, 0);
                    }
                }
            }
#pragma unroll
            for (int qt = 0; qt < 2; ++qt) {
                const int tl = (i0 + 16 * qt + q) * dil + rr, tlb = tl - 512 * blk;
                const float inv = __builtin_amdgcn_rcpf(ls[qt]), lse = mx[qt] + __builtin_amdgcn_logf(ls[qt]);
                if (grp < 2) {
                    unsigned ow[8];
#pragma unroll
                    for (int dt = 0; dt < 4; ++dt) { ow[2 * dt] = cvt_pk_bf16(O[qt][dt][0] * inv, O[qt][dt][1] * inv); ow[2 * dt + 1] = cvt_pk_bf16(O[qt][dt][2] * inv, O[qt][dt][3] * inv); }
                    *(LAS v4u*)(OX + ox_off(grp, tlb, 2 * g4)) = (v4u){ow[0], ow[1], ow[2], ow[3]};
                    *(LAS v4u*)(OX + ox_off(grp, tlb, 2 * g4 + 1)) = (v4u){ow[4], ow[5], ow[6], ow[7]};
                    if (g4 == 0) LSE[grp * 512 + tlb] = lse;
                } else {
                    const float l0 = LSE[tlb], l1 = LSE[512 + tlb];
                    const float mm = fmaxf(lse, fmaxf(l0, l1));
                    const float w0 = fast_exp2(l0 - mm), w1 = fast_exp2(l1 - mm), w2 = fast_exp2(lse - mm);
                    const float wn = __builtin_amdgcn_rcpf(w0 + w1 + w2), c0 = w0 * wn, c1 = w1 * wn, c2 = w2 * wn * inv;
                    const v4u a0 = *(const LAS v4u*)(OX + ox_off(0, tlb, 2 * g4)), a1 = *(const LAS v4u*)(OX + ox_off(0, tlb, 2 * g4 + 1));
                    const v4u b0 = *(const LAS v4u*)(OX + ox_off(1, tlb, 2 * g4)), b1 = *(const LAS v4u*)(OX + ox_off(1, tlb, 2 * g4 + 1));
                    const unsigned aw[8] = {a0.x, a0.y, a0.z, a0.w, a1.x, a1.y, a1.z, a1.w}, bw[8] = {b0.x, b0.y, b0.z, b0.w, b1.x, b1.y, b1.z, b1.w};
                    const bf16* gp = QKG + (size_t)tl * LDQ1 + 6144 + h * 64 + 16 * g4;
                    const v4u gg0 = *(const v4u*)gp, gg1 = *(const v4u*)(gp + 8);
                    const unsigned gw[8] = {gg0.x, gg0.y, gg0.z, gg0.w, gg1.x, gg1.y, gg1.z, gg1.w};
                    unsigned ow[8];
#pragma unroll
                    for (int dt = 0; dt < 4; ++dt) {
                        const float e0 = c0 * bflo(aw[2 * dt]) + c1 * bflo(bw[2 * dt]) + c2 * O[qt][dt][0], e1 = c0 * bfhi(aw[2 * dt]) + c1 * bfhi(bw[2 * dt]) + c2 * O[qt][dt][1];
                        const float e2 = c0 * bflo(aw[2 * dt + 1]) + c1 * bflo(bw[2 * dt + 1]) + c2 * O[qt][dt][2], e3 = c0 * bfhi(aw[2 * dt + 1]) + c1 * bfhi(bw[2 * dt + 1]) + c2 * O[qt][dt][3];
                        ow[2 * dt] = cvt_pk_bf16(e0 * silu_f(bflo(gw[2 * dt])), e1 * silu_f(bfhi(gw[2 * dt])));
                        ow[2 * dt + 1] = cvt_pk_bf16(e2 * silu_f(bflo(gw[2 * dt + 1])), e3 * silu_f(bfhi(gw[2 * dt + 1])));
                    }
                    bf16* op = OG + (size_t)tl * D + h * 64 + 16 * g4;
                    *(v4u*)op = (v4u){ow[0], ow[1], ow[2], ow[3]}; *(v4u*)(op + 8) = (v4u){ow[4], ow[5], ow[6], ow[7]};
                }
            }
        }
    }
}
#else
__device__ __forceinline__ void attn_b_phase(Frame& F, int b) {
    const bf16* QKG = (const bf16*)(F.ws + WS_QKG1); const bf16* VT = (const bf16*)(F.ws + WS_VT1); bf16* OG = (bf16*)(F.ws + (b == 0 ? WS_OG1A : WS_OG1B));
    const int gw = F.vcu * NWAVES + F.wave, NGW = F.G * NWAVES, lane = F.lane;
    for (int it = gw; it < SEQ * H; it += NGW) {
        const int tl = it >> 4, h = it & 15;
        const float slope2 = exp2f(-0.5f * (float)(h + 1)) * LOG2E;
        float og[3], lse[3];
#pragma unroll
        for (int g = 0; g < 3; ++g) {
            const int sh = 2 * g, dil = 1 << sh, L = SEQ >> sh, i = tl >> sh, rr = tl & (dil - 1);
            const float qd = bf2f(QKG[(size_t)tl * LDQ1 + g * 2048 + h * 64 + lane]);
            float m = -1e30f, l = 0.f, o = 0.f;
            for (int j = -64; j <= 64; ++j) {
                const int ki = i + j; if (ki < 0 || ki >= L) continue;
                const int ktl = ki * dil + rr;
                const float s = wave_sum(qd * bf2f(QKG[(size_t)ktl * LDQ1 + g * 2048 + 1024 + h * 64 + lane])) - slope2 * (float)(abs(j) * dil);
                const float mn = fmaxf(m, s), al = fast_exp2(m - mn), p = fast_exp2(s - mn);
                l = l * al + p; o = o * al + p * bf2f(VT[(size_t)(g * 1024 + h * 64 + lane) * SEQ + rr * L + ki]); m = mn;
            }
            og[g] = o / l; lse[g] = m + log2f(l);
        }
        const float mx = fmaxf(lse[0], fmaxf(lse[1], lse[2]));
        const float w0 = fast_exp2(lse[0] - mx), w1 = fast_exp2(lse[1] - mx), w2 = fast_exp2(lse[2] - mx);
        const float o = (w0 * og[0] + w1 * og[1] + w2 * og[2]) / (w0 + w1 + w2);
        const float g = bf2f(QKG[(size_t)tl * LDQ1 + 6144 + h * 64 + lane]);
        OG[(size_t)tl * D + h * 64 + lane] = (bf16)f2bf(o * silu_f(g));
    }
}
#endif

__device__ __forceinline__ void final_phase(Frame& F) {
    const float* ss = (const float*)(F.ws + WS_SS2);
    const int gw = F.vcu * NWAVES + F.wave, NGW = F.G * NWAVES;
    for (int m = gw; m < M; m += NGW) {
        float s = (F.lane < 16) ? ss[(size_t)F.lane * M + m] : 0.f;
        const float rstd = __builtin_amdgcn_rsqf(wave_sum(s) * (1.0f / D) + RMS_EPS);
        f32x4* xr = (f32x4*)(F.out + (size_t)m * D) + F.lane; const f32x4* gr = (const f32x4*)F.gf + F.lane;
#pragma unroll
        for (int j = 0; j < 4; ++j) { const f32x4 v = xr[64 * j], g = gr[64 * j]; xr[64 * j] = v * rstd * g; }
    }
}

struct Args { const float* in[9]; float* out; unsigned char* ws; };
__global__ void __launch_bounds__(NWAVES * 64, 2) fwd_megakernel(Args args) {
    extern __shared__ __attribute__((aligned(16))) unsigned char lds_raw[];
    Frame F;
    F.lds = (LAS unsigned char*)lds_raw;
    F.tid = threadIdx.x; F.lane = F.tid & 63; F.wave = __builtin_amdgcn_readfirstlane(F.tid >> 6);
    F.G = gridDim.x; { const int bx = blockIdx.x; F.vcu = (F.G % 8 == 0) ? (bx % 8) * (F.G / 8) + bx / 8 : bx; }
    F.x = args.in[0]; F.g0 = args.in[1]; F.w_in0 = args.in[2]; F.rpb = args.in[3]; F.w_out0 = args.in[4]; F.g1 = args.in[5]; F.w_in1 = args.in[6]; F.w_out1 = args.in[7]; F.gf = args.in[8];
    F.out = args.out; F.ws = args.ws;
    volatile LAS unsigned* MISC = (volatile LAS unsigned*)(F.lds + MISC_OFF);
    for (int u = F.tid; u < 128; u += NWAVES * 64) MISC[u] = 0u;
    __syncthreads();
    XcdBarrier bar = xcd_barrier_post((unsigned*)(F.ws + WS_CTL), MISC + 8);
#define GRID_BAR() xcd_barrier(bar)
    const int G = F.G, c = (int)blockIdx.x;

    p0_prologue(F);
    GRID_BAR();
    {
        ProjSched S{64, 16, 12, G, c, 0, (const char*)(F.ws + WS_XB), (const char*)(F.ws + WS_WT0), 3072};
        EpiProj E{(bf16*)(F.ws + WS_QKG0), LDQ0, 12, (bf16*)(F.ws + WS_VT0), M, nullptr, 0, 0};
        gemm_phase<EpiProj, ProjSched, true>(F.lds, S, E);
    }
    GRID_BAR();
    attn_a_phase(F);
    GRID_BAR();
    {
        OutSched S{64, 4, G, c, (const char*)(F.ws + WS_OG0), (const char*)(F.ws + WS_OG0), 64, (const char*)(F.ws + WS_WO0)};
        EpiRes E{F.x, F.out, (bf16*)(F.ws + WS_XB), (float*)(F.ws + WS_SS1)};
        gemm_phase<EpiRes, OutSched, false>(F.lds, S, E);
    }
    GRID_BAR();
    for (int b = 0; b < BATCH; ++b) {
        {
            ProjSched S{32, 40, 28, G, c, 1, (const char*)(F.ws + WS_XB) + (size_t)b * SEQ * KDIM * 2, (const char*)(F.ws + WS_WT1), 7168};
            EpiProj E{(bf16*)(F.ws + WS_QKG1), LDQ1, 28, (bf16*)(F.ws + WS_VT1), SEQ, (const float*)(F.ws + WS_SS1), b * SEQ, 1};
            gemm_phase<EpiProj, ProjSched, true>(F.lds, S, E);
        }
        GRID_BAR();
        attn_b_phase(F, b);
        GRID_BAR();
    }
    {
        OutSched S{64, 4, G, c, (const char*)(F.ws + WS_OG1A), (const char*)(F.ws + WS_OG1B), 32, (const char*)(F.ws + WS_WO1)};
        EpiRes E{F.out, F.out, nullptr, (float*)(F.ws + WS_SS2)};
        gemm_phase<EpiRes, OutSched, false>(F.lds, S, E);
    }
    GRID_BAR();
    final_phase(F);
}

extern "C" void kernel_launch(void* const* d_in, const int* in_sizes, int n_in, void* d_out, int out_size, void* d_ws, size_t ws_size, hipStream_t stream) {
    static int grid = 0;
    if (grid == 0) {
        if (n_in != 9 || in_sizes[0] != M * D || out_size != M * D || ws_size < WS_END) {
            fprintf(stderr, "kernel_launch: unexpected shapes (n_in %d, in0 %d, out %d, ws %zu); nothing launched\n", n_in, n_in > 0 ? in_sizes[0] : -1, out_size, ws_size); grid = -1; return; }
        int dev = 0, cus = 0, per_cu = 0;
        if (hipGetDevice(&dev) != hipSuccess || hipDeviceGetAttribute(&cus, hipDeviceAttributeMultiprocessorCount, dev) != hipSuccess) { grid = -1; return; }
        if (hipFuncSetAttribute((const void*)fwd_megakernel, hipFuncAttributeMaxDynamicSharedMemorySize, LDS_BYTES) != hipSuccess) { fprintf(stderr, "kernel_launch: hipFuncSetAttribute failed\n"); grid = -1; return; }
        if (hipOccupancyMaxActiveBlocksPerMultiprocessor(&per_cu, (const void*)fwd_megakernel, NWAVES * 64, LDS_BYTES) != hipSuccess || per_cu < 1) {
            fprintf(stderr, "kernel_launch: occupancy query says %d blocks per CU; nothing launched\n", per_cu); (void)hipGetLastError(); grid = -1; return; }
        grid = cus;
        if (grid != 256) fprintf(stderr, "kernel_launch: note: %d CUs (tuned for 256)\n", grid);
    }
    if (grid < 0) return;
    if (hipMemsetAsync((char*)d_ws + WS_CTL, 0, CTL_ZERO_BYTES, stream) != hipSuccess) return;
    Args a{};
    for (int i = 0; i < 9; ++i) a.in[i] = (const float*)d_in[i];
    a.out = (float*)d_out; a.ws = (unsigned char*)d_ws;
    void* kargs[] = {&a};
    const hipError_t e = hipLaunchCooperativeKernel((const void*)fwd_megakernel, dim3(grid), dim3(NWAVES * 64), kargs, LDS_BYTES, stream);
    if (e != hipSuccess) fprintf(stderr, "kernel_launch: cooperative launch failed: %s (grid %d)\n", hipGetErrorString(e), grid);
}
```

```cpp
#include <hip/hip_runtime.h>
#include <cstdio>
#include <cstdint>

#ifndef FAST_GEMM
#define FAST_GEMM 1
#endif
#ifndef FAST_ATTN_A
#define FAST_ATTN_A 1
#endif
#ifndef REP_P0
#define REP_P0 1
#endif
#ifndef REP_G1
#define REP_G1 1
#endif
#ifndef REP_A0
#define REP_A0 1
#endif
#ifndef REP_G2
#define REP_G2 1
#endif
#ifndef REP_G3
#define REP_G3 1
#endif
#ifndef REP_A1
#define REP_A1 1
#endif
#ifndef FAST_ATTN_B
#define FAST_ATTN_B 1
#endif

#define GAS __attribute__((address_space(1)))
#define LAS __attribute__((address_space(3)))
typedef unsigned short bf16;
typedef unsigned v4u __attribute__((ext_vector_type(4)));
typedef unsigned v2u __attribute__((ext_vector_type(2)));
typedef float f32x4 __attribute__((ext_vector_type(4)));
typedef float f32x2 __attribute__((ext_vector_type(2)));
typedef short bf16x8 __attribute__((ext_vector_type(8)));
typedef GAS unsigned gu32;

constexpr int NWAVES = 8;
constexpr int BATCH = 2, SEQ = 8192, D = 1024, H = 16, HD = 64;
constexpr int M = BATCH * SEQ;
constexpr int N0 = 4096, N1 = 10240;
constexpr float RMS_EPS = 1e-6f;
constexpr float LOG2E = 1.4426950408889634f;
constexpr float QSCALE = 0.125f * LOG2E;

constexpr size_t MiB = 1u << 20;
constexpr size_t WS_CTL = 0, CTL_ZERO_BYTES = 65536;
constexpr size_t WS_WT0 = 1 * MiB;
constexpr size_t WS_WO0 = 9 * MiB;
constexpr size_t WS_WT1 = 11 * MiB;
constexpr size_t WS_WO1 = 31 * MiB;
constexpr size_t WS_SS1 = 33 * MiB;
constexpr size_t WS_SS2 = 34 * MiB;
constexpr size_t WS_XB = 36 * MiB;
constexpr size_t WS_BIG = 68 * MiB;
constexpr size_t WS_QK0 = WS_BIG;
constexpr size_t WS_G0 = WS_BIG + 64 * MiB;
constexpr size_t WS_VT0 = WS_BIG + 96 * MiB;
constexpr size_t WS_OG0 = WS_BIG + 128 * MiB;
constexpr size_t WS_QK1 = WS_BIG;
constexpr size_t WS_G1 = WS_BIG + 96 * MiB;
constexpr size_t WS_VT1 = WS_BIG + 112 * MiB;
constexpr size_t WS_OG1A = WS_BIG + 160 * MiB;
constexpr size_t WS_OG1B = WS_XB;
constexpr size_t WS_LSE = WS_BIG + 176 * MiB;
constexpr size_t WS_END = WS_BIG + 177 * MiB;
static_assert(WS_END <= 256 * MiB, "ws map");

constexpr int RING_BYTES = 131072;
constexpr int MISC_OFF = RING_BYTES;
constexpr int LSE_OFF = RING_BYTES + 512;
constexpr int SC_OFF = LSE_OFF + 4096;
constexpr int LDS_BYTES = 147456;
static_assert(SC_OFF + 8 * 1024 <= LDS_BYTES, "lds map");

#define RLX_AGENT __ATOMIC_RELAXED, __HIP_MEMORY_SCOPE_AGENT
#define LDS_WAIT() asm volatile("s_waitcnt lgkmcnt(0)" ::: "memory")
#define VM_WAIT() asm volatile("s_waitcnt vmcnt(0)" ::: "memory")
__device__ __forceinline__ unsigned f2bf(float f) { unsigned u = __builtin_bit_cast(unsigned, f); return (u + 0x7fffu + ((u >> 16) & 1u)) >> 16; }
__device__ __forceinline__ unsigned pk2(float lo, float hi) { return f2bf(lo) | (f2bf(hi) << 16); }
__device__ __forceinline__ float bf2f(unsigned short b) { return __builtin_bit_cast(float, (unsigned)b << 16); }
__device__ __forceinline__ float bflo(unsigned w) { return __builtin_bit_cast(float, w << 16); }
__device__ __forceinline__ float bfhi(unsigned w) { return __builtin_bit_cast(float, w & 0xffff0000u); }
typedef __bf16 bf16x2_t __attribute__((ext_vector_type(2)));
__device__ __forceinline__ unsigned cvt_pk_bf16(float lo, float hi) { const f32x2 v = {lo, hi}; const bf16x2_t b = __builtin_convertvector(v, bf16x2_t); return __builtin_bit_cast(unsigned, b); }
__device__ __forceinline__ float wave_sum(float v) {
#pragma unroll
    for (int o = 1; o < 64; o <<= 1) v += __shfl_xor(v, o);
    return v;
}
__device__ __forceinline__ float fast_exp2(float x) { return __builtin_amdgcn_exp2f(x); }
__device__ __forceinline__ float silu_f(float g) { return g * __builtin_amdgcn_rcpf(1.0f + fast_exp2(-g * LOG2E)); }
__device__ __forceinline__ float rstd16(const float* ss, int tok) {
    float s = 0.f;
#pragma unroll
    for (int p = 0; p < 16; ++p) s += ss[p * M + tok];
    return __builtin_amdgcn_rsqf(s * (1.0f / D) + RMS_EPS);
}

#define XB_TMO      128
#define XB_XCNT(j)  (256  + 64 * (j))
#define XB_XSUB(j)  (1280 + 64 * (j))
#define XB_XGEN(j)  (2304 + 64 * (j))
#define XB_TOP      3328
#define XB_TOPGEN   3392
#define XCD_BAR_WORDS 3456
#define XB_SPIN_CAP (1u << 20)
__device__ __forceinline__ unsigned xb_ld(unsigned* p)              { return __hip_atomic_load(p, __ATOMIC_RELAXED, __HIP_MEMORY_SCOPE_AGENT); }
__device__ __forceinline__ unsigned xb_add(unsigned* p, unsigned v) { return __hip_atomic_fetch_add(p, v, __ATOMIC_RELAXED, __HIP_MEMORY_SCOPE_AGENT); }
__device__ __forceinline__ unsigned xb_xcc_id() { return (unsigned)__builtin_amdgcn_s_getreg((3 << 11) | 20) & 0xFu; }
#define XB_SPIN(cond, bar) do { unsigned _sp = 0; while (cond) { __builtin_amdgcn_s_sleep(1); \
    if ((++_sp & 255u) == 0u) { if (xb_ld(&(bar)[XB_TMO])) break; if (_sp > XB_SPIN_CAP) { atomicAdd(&(bar)[XB_TMO], 1u); break; } } } } while (0)
struct XcdBarrier { unsigned* bar; unsigned x; volatile LAS unsigned* st; };
__device__ __forceinline__ XcdBarrier xcd_barrier_post(unsigned* bar, volatile LAS unsigned* st) {
    XcdBarrier b; b.bar = bar; b.x = xb_xcc_id(); b.st = st;
    if (threadIdx.x == 0) (void)xb_add(&bar[XB_XCNT(b.x)], 1u);
    return b;
}
__device__ __forceinline__ void xcd_barrier_complete(unsigned* bar, unsigned x, unsigned& nloc, unsigned& nx) {
    const unsigned G = gridDim.x * gridDim.y * gridDim.z;
    unsigned sum, cnt, mine, sp = 0u;
    for (;;) {
        sum = 0u; cnt = 0u; mine = 0u;
#pragma unroll
        for (unsigned j = 0; j < 16; ++j) { const unsigned c = xb_ld(&bar[XB_XCNT(j)]); sum += c; cnt += (c > 0u) ? 1u : 0u; mine = (j == x) ? c : mine; }
        if (sum == G) break;
        __builtin_amdgcn_s_sleep(1);
        if ((++sp & 255u) == 0u) { if (xb_ld(&bar[XB_TMO])) break; if (sp > XB_SPIN_CAP) { atomicAdd(&bar[XB_TMO], 1u); break; } }
    }
    nloc = mine > 0u ? mine : 1u; nx = cnt > 0u ? cnt : 1u;
}
__device__ __forceinline__ void xcd_barrier(const XcdBarrier& b) {
    asm volatile("s_waitcnt vmcnt(0)" ::: "memory");
    __syncthreads();
    if (threadIdx.x == 0) {
        unsigned* bar = b.bar; unsigned bx = b.x; asm volatile("" : "+s"(bar), "+s"(bx));
        __builtin_amdgcn_s_waitcnt(0);
        unsigned nloc = b.st[0], nx = b.st[1];
        if (nloc == 0u) { xcd_barrier_complete(bar, bx, nloc, nx); b.st[0] = nloc; b.st[1] = nx; }
        const unsigned old = xb_add(&bar[XB_XSUB(bx)], 1u);
        const unsigned gen = old / nloc;
        if (old + 1u == (gen + 1u) * nloc) {
            __builtin_amdgcn_fence(__ATOMIC_RELEASE, "agent");
            asm volatile("s_waitcnt vmcnt(0)" ::: "memory");
            const unsigned og = xb_add(&bar[XB_TOP], 1u);
            const unsigned tg = og / nx;
            if (og + 1u == (tg + 1u) * nx) xb_add(&bar[XB_TOPGEN], 1u);
            else XB_SPIN(xb_ld(&bar[XB_TOPGEN]) == tg, bar);
            __builtin_amdgcn_fence(__ATOMIC_ACQUIRE, "agent");
            xb_add(&bar[XB_XGEN(bx)], 1u);
            asm volatile("s_waitcnt vmcnt(0)" ::: "memory");
        } else {
            XB_SPIN(xb_ld(&bar[XB_XGEN(bx)]) == gen, bar);
            __builtin_amdgcn_fence(__ATOMIC_ACQUIRE, "agent");
            asm volatile("s_waitcnt vmcnt(0)" ::: "memory");
        }
    }
    __syncthreads();
}

constexpr int BM = 256, BK = 64, HALF = 128, HTB = HALF * BK * 2, NXCD = 8, WGM = 8, KDIM = 1024;
__device__ __forceinline__ int lds_byte(int r, int c) { const int st = (r >> 4) * 2 + (c >> 5), rr = r & 15, cc = c & 31, ob = rr * 64 + cc * 2; return st * 1024 + (ob ^ (((ob >> 9) & 1) << 5)); }
__device__ __forceinline__ void stage_rc(int b, int& R, int& C) { const int st = b / 1024, sb = b % 1024, swz = sb ^ (((sb >> 9) & 1) << 5); R = (st >> 1) * 16 + swz / 64; C = (st & 1) * 32 + (swz % 64) / 2; }
__device__ __forceinline__ int perm32(int rho) { const int n = rho >> 4, i = rho & 15; return 8 * (i >> 2) + 4 * n + (i & 3); }

struct GUnit { const char* A; const char* B; unsigned rsA, rsB; int pm, pn, tr; };
__device__ __forceinline__ void vt_tile_tokens(int layer, int j, int pm, int& tok0, int& dil) {
    dil = 1; tok0 = 256 * pm;
    if (layer == 1) { const int sh = 2 * (j >> 2); dil = 1 << sh; const int L = SEQ >> sh; tok0 = ((256 * pm) % L) * dil + (256 * pm) / L; }
}

__device__ __forceinline__ bool tile_order(int i, int G, int c, int nM, int nN, int& pm, int& pn) {
    const int nwg = nM * nN; const long L = (long)i * G + c; if (L >= nwg) return false;
    int wgid = (int)L; { const int q = nwg / NXCD, r = nwg % NXCD, xcd = wgid % NXCD, off = wgid / NXCD; wgid = (xcd < r ? xcd * (q + 1) : r * (q + 1) + (xcd - r) * q) + off; }
    const int nig = WGM * nN, gid = wgid / nig, fm = gid * WGM, gsz = (nM - fm) < WGM ? (nM - fm) : WGM;
    pm = fm + ((wgid % nig) % gsz); pn = (wgid % nig) / gsz; return true;
}

struct ProjSched {
    int nM, nN, nNorm, G, c, layer; const char* X; const char* W; int vrow0;
    __device__ __forceinline__ bool next(int i, GUnit& u) const {
        int pm, pn; if (!tile_order(i, G, c, nM, nN, pm, pn)) return false;
        u.pm = pm; u.pn = pn; u.rsA = KDIM * 2; u.rsB = KDIM * 2;
        if (pn < nNorm) {
            u.tr = 0; u.B = W + (size_t)pn * 256 * KDIM * 2;
            int tok0 = 256 * pm, dil = 1;
            if (layer == 1 && pn < 24) vt_tile_tokens(1, 4 * (pn >> 3), pm, tok0, dil);
            u.A = X + (size_t)tok0 * KDIM * 2; u.rsA = (unsigned)dil * KDIM * 2;
        } else {
            const int j = pn - nNorm; u.tr = 1; u.A = W + (size_t)(vrow0 + 256 * j) * KDIM * 2;
            int tok0, dil; vt_tile_tokens(layer, j, pm, tok0, dil);
            u.B = X + (size_t)tok0 * KDIM * 2; u.rsB = (unsigned)dil * KDIM * 2;
        }
        return true;
    }
};
__device__ __forceinline__ void unit_tokens(int layer, int nNorm, const GUnit& u, int& tok0, int& dil) {
    tok0 = 256 * u.pm; dil = 1;
    if (u.tr) vt_tile_tokens(layer, u.pn - nNorm, u.pm, tok0, dil);
    else if (layer == 1 && u.pn < 24) vt_tile_tokens(1, 4 * (u.pn >> 3), u.pm, tok0, dil);
}
struct OutSched {
    int nM, nN, G, c; const char* A0; const char* A1; int split_pm; const char* W;
    __device__ __forceinline__ bool next(int i, GUnit& u) const {
        int pm, pn; if (!tile_order(i, G, c, nM, nN, pm, pn)) return false;
        u.pm = pm; u.pn = pn; u.tr = 0; u.rsA = KDIM * 2; u.rsB = KDIM * 2;
        u.A = (pm < split_pm) ? A0 + (size_t)pm * 256 * KDIM * 2 : A1 + (size_t)(pm - split_pm) * 256 * KDIM * 2;
        u.B = W + (size_t)pn * 256 * KDIM * 2; return true;
    }
};

struct EpiProj {
    bf16* QK; bf16* G; bf16* VT; int nNorm; int T; int PB; const float* ss; int tok_base; int layer; const LAS float* lsc;
    __device__ __forceinline__ void prep(const GUnit& u, int ui, int wr, int wc, int fr, int fq, float (&cs)[2][8]) const {
#pragma unroll
        for (int a = 0; a < 2; ++a)
#pragma unroll
            for (int e = 0; e < 8; ++e) cs[a][e] = 1.0f;
        if (ss) {
            const LAS float* tab = lsc + ui * 256;
            if (u.tr) {
#pragma unroll
                for (int a = 0; a < 2; ++a) { const f32x4 t0 = *(const LAS f32x4*)(tab + a * HALF + wc * 32 + 8 * fq), t1 = *(const LAS f32x4*)(tab + a * HALF + wc * 32 + 8 * fq + 4);
                    cs[a][0] = t0[0]; cs[a][1] = t0[1]; cs[a][2] = t0[2]; cs[a][3] = t0[3]; cs[a][4] = t1[0]; cs[a][5] = t1[1]; cs[a][6] = t1[2]; cs[a][7] = t1[3]; }
            } else {
#pragma unroll
                for (int a = 0; a < 2; ++a)
#pragma unroll
                    for (int m = 0; m < 4; ++m) cs[a][m] = tab[a * HALF + wr * 64 + m * 16 + fr];
            }
        }
    }
    template <class Sched> __device__ __forceinline__ void fill_scales(const Sched& S, int tid) const {
        if (!ss) return;
        GUnit u;
        for (int i0 = 0; S.next(i0, u); i0 += 2) {
            const int i = i0 + (tid >> 8), t = tid & 255;
            if (S.next(i, u)) {
                int tok0, dil; unit_tokens(layer, nNorm, u, tok0, dil);
                const int tok = tok_base + tok0 + t * dil;
                ((LAS float*)lsc)[i * 256 + t] = rstd16(ss, tok);
            }
        }
        __syncthreads();
    }
    __device__ __forceinline__ void rowgroup(const f32x4 (&a)[2][2], const GUnit& u, int ai, int m, int wr, int wc, int fr, int fq, const float (&cs)[2][8]) const {
        if (!u.tr) {
            const int row = u.pm * 256 + ai * HALF + wr * 64 + m * 16 + fr;
            const float sc = cs[ai][m];
            const int sec = u.pn >> 2, c0 = (u.pn & 3) * 256 + wc * 32 + 8 * fq;
            const bool gate = (sec == (layer ? 6 : 2));
#pragma unroll
            for (int bj = 0; bj < 2; ++bj) { const f32x4 v0 = a[bj][0] * sc, v1 = a[bj][1] * sc; const int c = c0 + bj * HALF;
                v4u w; w.x = cvt_pk_bf16(v0[0], v0[1]); w.y = cvt_pk_bf16(v0[2], v0[3]); w.z = cvt_pk_bf16(v1[0], v1[1]); w.w = cvt_pk_bf16(v1[2], v1[3]);
                bf16* p = gate ? G + (size_t)row * D + c : QK + ((size_t)(sec * H + (c >> 6)) * T + row) * 64 + (c & 63);
                *(v4u*)p = w; }
        } else {
            const int j = u.pn - nNorm, g = j >> 2, fb = j & 3;
            const int f = fb * 256 + ai * HALF + wr * 64 + m * 16 + fr, h = f >> 6, d = f & 63;
#pragma unroll
            for (int bj = 0; bj < 2; ++bj) { const f32x4 v0 = a[bj][0], v1 = a[bj][1]; const int pos = u.pm * 256 + bj * HALF + wc * 32 + 8 * fq;
                v4u w; w.x = cvt_pk_bf16(v0[0] * cs[bj][0], v0[1] * cs[bj][1]); w.y = cvt_pk_bf16(v0[2] * cs[bj][2], v0[3] * cs[bj][3]);
                w.z = cvt_pk_bf16(v1[0] * cs[bj][4], v1[1] * cs[bj][5]); w.w = cvt_pk_bf16(v1[2] * cs[bj][6], v1[3] * cs[bj][7]);
                *(v4u*)(VT + (((size_t)(g * H + h) * (T / PB) + pos / PB) * 64 + d) * PB + (pos % PB)) = w; }
        }
    }
};
struct EpiRes {
    const float* resid; float* out; bf16* xb; float* ss;
    template <class Sched> __device__ __forceinline__ void fill_scales(const Sched&, int) const {}
    __device__ __forceinline__ void prep(const GUnit&, int, int, int, int, int, float (&cs)[2][8]) const {
#pragma unroll
        for (int bj = 0; bj < 2; ++bj)
#pragma unroll
            for (int e = 0; e < 8; ++e) cs[bj][e] = 1.0f;
    }
    __device__ __forceinline__ void rowgroup(const f32x4 (&a)[2][2], const GUnit& u, int ai, int m, int wr, int wc, int fr, int fq, const float (&)[2][8]) const {
        const int row = u.pm * 256 + ai * HALF + wr * 64 + m * 16 + fr;
        const size_t off = (size_t)row * D + u.pn * 256 + wc * 32 + 8 * fq;
        float q = 0.f;
#pragma unroll
        for (int bj = 0; bj < 2; ++bj) {
            const f32x4 r0 = *(const f32x4*)(resid + off + bj * HALF), r1 = *(const f32x4*)(resid + off + bj * HALF + 4);
            const f32x4 v0 = a[bj][0] + r0, v1 = a[bj][1] + r1;
            *(f32x4*)(out + off + bj * HALF) = v0; *(f32x4*)(out + off + bj * HALF + 4) = v1;
            q += (v0[0] * v0[0] + v0[1] * v0[1]) + (v0[2] * v0[2] + v0[3] * v0[3]) + (v1[0] * v1[0] + v1[1] * v1[1]) + (v1[2] * v1[2] + v1[3] * v1[3]);
            if (xb) { v4u w; w.x = cvt_pk_bf16(v0[0], v0[1]); w.y = cvt_pk_bf16(v0[2], v0[3]); w.z = cvt_pk_bf16(v1[0], v1[1]); w.w = cvt_pk_bf16(v1[2], v1[3]);
                *(v4u*)(xb + off + bj * HALF) = w; }
        }
        q += __shfl_xor(q, 16); q += __shfl_xor(q, 32);
        if (fq == 0) ss[(size_t)(u.pn * 4 + wc) * M + row] = q;
    }
};
template <class Epi>
__device__ __forceinline__ void epi_tile(const Epi& E, const f32x4 (&acc)[2][2][4][2], const GUnit& u, int ui, int wr, int wc, int fr, int fq) {
    float cs[2][8]; E.prep(u, ui, wr, wc, fr, fq, cs);
#pragma unroll
    for (int ai = 0; ai < 2; ++ai)
#pragma unroll
        for (int m = 0; m < 4; ++m) { const f32x4 a[2][2] = {{acc[ai][0][m][0], acc[ai][0][m][1]}, {acc[ai][1][m][0], acc[ai][1][m][1]}}; E.rowgroup(a, u, ai, m, wr, wc, fr, fq, cs); }
}

#if FAST_GEMM
template <class Epi, class Sched, bool ALIGN_EPI>
__device__ __forceinline__ void gemm_phase(LAS unsigned char* lds, const Sched& S, const Epi& E) {
    int tid_ = threadIdx.x; asm volatile("" : "+v"(tid_));
    const int tid = tid_, wid = __builtin_amdgcn_readfirstlane(tid >> 6), lane = tid & 63, wr = wid >> 2, wc = wid & 3, fr = lane & 15, fq = lane >> 4;
    constexpr int nt = KDIM / BK;
    E.fill_scales(S, tid);
    unsigned RA[2], RB[2], CC[2];
#pragma unroll
    for (int i = 0; i < 2; ++i) { int R, C; stage_rc(tid * 16 + i * 8192, R, C); RA[i] = (unsigned)R; RB[i] = (unsigned)((R & ~31) + perm32(R & 31)); CC[i] = (unsigned)C * 2u; }
    const size_t kstep = (size_t)(BK * 2);
    const unsigned ldsw = (unsigned)wid * 1024u;
    const int aoff = lds_byte(wr * 64 + fr, fq * 8), boff = lds_byte(wc * 32 + fr, fq * 8);
#define PG8_SA(b, h) (((b) * 2 + (h)) * HTB)
#define PG8_SB(b, h) ((4 + (b) * 2 + (h)) * HTB)
#define PG8_STAGE(bufoff, gbase, voff) do { _Pragma("unroll") for (int _i = 0; _i < 2; ++_i) \
        __builtin_amdgcn_global_load_lds((const unsigned*)((const char*)(gbase) + (voff)[_i]), (LAS unsigned*)(lds + (bufoff) + ldsw + _i * 8192), 16, 0, 0); } while (0)
#define PG8_STAGEA(bufoff, gbase, rs) do { _Pragma("unroll") for (int _i = 0; _i < 2; ++_i) \
        __builtin_amdgcn_global_load_lds((const unsigned*)((const char*)(gbase) + (RA[_i] * (rs) + CC[_i])), (LAS unsigned*)(lds + (bufoff) + ldsw + _i * 8192), 16, 0, 0); } while (0)
#define PG8_STAGEB(bufoff, gbase, rs) do { _Pragma("unroll") for (int _i = 0; _i < 2; ++_i) \
        __builtin_amdgcn_global_load_lds((const unsigned*)((const char*)(gbase) + (RB[_i] * (rs) + CC[_i])), (LAS unsigned*)(lds + (bufoff) + ldsw + _i * 8192), 16, 0, 0); } while (0)
#define PG8_LDA(dst, b, h) do { _Pragma("unroll") for (int m = 0; m < 4; ++m) _Pragma("unroll") for (int k = 0; k < 2; ++k) dst[m][k] = *(const LAS bf16x8*)(lds + PG8_SA(b, h) + aoff + m * 2048 + k * 1024); } while (0)
#define PG8_LDB(dst, b, h) do { _Pragma("unroll") for (int n = 0; n < 2; ++n) _Pragma("unroll") for (int k = 0; k < 2; ++k) dst[n][k] = *(const LAS bf16x8*)(lds + PG8_SB(b, h) + boff + n * 2048 + k * 1024); } while (0)
#define PG8_MMA(ai, bj, At, Bt) do { __builtin_amdgcn_s_setprio(1); _Pragma("unroll") for (int m = 0; m < 4; ++m) _Pragma("unroll") for (int n = 0; n < 2; ++n) _Pragma("unroll") for (int k = 0; k < 2; ++k) \
        acc[ai][bj][m][n] = __builtin_amdgcn_mfma_f32_16x16x32_bf16(Bt[n][k], At[m][k], acc[ai][bj][m][n], 0, 0, 0); __builtin_amdgcn_s_setprio(0); } while (0)
#define PG8_WAIT_V(n) asm volatile("s_waitcnt vmcnt(" #n ")" ::: "memory")
#define PG8_WAIT_L(n) asm volatile("s_waitcnt lgkmcnt(" #n ")" ::: "memory")
#define PG8_BAR __builtin_amdgcn_s_barrier()
#define PG8_SCHED __builtin_amdgcn_sched_barrier(0)
    GUnit cur, nxt; int ui = 0;
    if (!S.next(0, cur)) return;
    f32x4 acc[2][2][4][2];
#pragma unroll
    for (int a = 0; a < 2; ++a)
#pragma unroll
        for (int b = 0; b < 2; ++b)
#pragma unroll
            for (int m = 0; m < 4; ++m)
#pragma unroll
                for (int n = 0; n < 2; ++n) acc[a][b][m][n] = (f32x4){0.f, 0.f, 0.f, 0.f};
    bf16x8 At[4][2], B0[2][2], B1[2][2];
    const char* cA = cur.A; const char* cB = cur.B;
    unsigned rA = cur.rsA, rB = cur.rsB; size_t hA = (size_t)HALF * cur.rsA, hB = (size_t)HALF * cur.rsB;
    PG8_STAGEB(PG8_SB(0, 0), cB, rB); PG8_STAGEB(PG8_SB(0, 1), cB + hB, rB); PG8_STAGEA(PG8_SA(0, 0), cA, rA); PG8_STAGEA(PG8_SA(0, 1), cA + hA, rA);
    if (wr == 1) PG8_BAR;
    PG8_WAIT_V(2); PG8_BAR;
    PG8_STAGEB(PG8_SB(1, 0), cB + kstep, rB); PG8_STAGEA(PG8_SA(1, 0), cA + kstep, rA); PG8_STAGEB(PG8_SB(1, 1), cB + hB + kstep, rB);
    PG8_WAIT_V(6); PG8_BAR;
    for (;;) {
        const bool has_next = S.next(ui + 1, nxt);
        const char* nA = has_next ? nxt.A : cA; const char* nB = has_next ? nxt.B : cB;
        const unsigned nrA = has_next ? nxt.rsA : rA, nrB = has_next ? nxt.rsB : rB; const size_t nhA = (size_t)HALF * nrA, nhB = (size_t)HALF * nrB;
        for (int t = 0; t < nt; t += 2) {
            const bool last = (t == nt - 2);
            const char* a1 = cA + (size_t)(t + 1) * kstep;
            const char* a2 = last ? nA : cA + (size_t)(t + 2) * kstep; const char* b2 = last ? nB : cB + (size_t)(t + 2) * kstep;
            const char* a3 = a2 + kstep; const char* b3 = b2 + kstep;
            const unsigned wrA = last ? nrA : rA, wrB = last ? nrB : rB; const size_t gA = last ? nhA : hA, gB = last ? nhB : hB;
            PG8_LDB(B0, 0, 0); PG8_LDB(B1, 0, 1); PG8_SCHED; PG8_LDA(At, 0, 0); PG8_STAGEA(PG8_SA(1, 1), a1 + hA, rA);
            PG8_WAIT_V(8); PG8_WAIT_L(0); PG8_BAR; PG8_MMA(0, 0, At, B0); PG8_MMA(0, 1, At, B1); PG8_BAR; PG8_SCHED;
            PG8_LDA(At, 0, 1); PG8_STAGEB(PG8_SB(0, 0), b2, wrB); PG8_STAGEB(PG8_SB(0, 1), b2 + gB, wrB); PG8_STAGEA(PG8_SA(0, 0), a2, wrA);
            PG8_WAIT_V(8); PG8_WAIT_L(0); PG8_BAR; PG8_MMA(1, 0, At, B0); PG8_MMA(1, 1, At, B1); PG8_BAR; PG8_SCHED;
            PG8_LDB(B0, 1, 0); PG8_LDB(B1, 1, 1); PG8_SCHED; PG8_LDA(At, 1, 0); PG8_STAGEA(PG8_SA(0, 1), a2 + gA, wrA);
            PG8_WAIT_V(8); PG8_WAIT_L(0); PG8_BAR; PG8_MMA(0, 0, At, B0); PG8_MMA(0, 1, At, B1); PG8_BAR; PG8_SCHED;
            PG8_LDA(At, 1, 1); PG8_STAGEB(PG8_SB(1, 0), b3, wrB); PG8_STAGEB(PG8_SB(1, 1), b3 + gB, wrB); PG8_STAGEA(PG8_SA(1, 0), a3, wrA);
            PG8_WAIT_V(8); PG8_WAIT_L(0); PG8_BAR; PG8_MMA(1, 0, At, B0); PG8_MMA(1, 1, At, B1); PG8_BAR; PG8_SCHED;
        }
        if constexpr (ALIGN_EPI) { if (wr == 0) PG8_BAR; }
        epi_tile(E, acc, cur, ui, wr, wc, fr, fq);
        if (!has_next) break;
#pragma unroll
        for (int a = 0; a < 2; ++a)
#pragma unroll
            for (int b = 0; b < 2; ++b)
#pragma unroll
                for (int m = 0; m < 4; ++m)
#pragma unroll
                    for (int n = 0; n < 2; ++n) acc[a][b][m][n] = (f32x4){0.f, 0.f, 0.f, 0.f};
        cur = nxt; cA = nA; cB = nB; rA = nrA; rB = nrB; hA = nhA; hB = nhB; ++ui;
        if constexpr (ALIGN_EPI) { if (wr == 1) PG8_BAR; }
    }
    PG8_WAIT_V(0);
    if constexpr (!ALIGN_EPI) { if (wr == 0) PG8_BAR; }
    PG8_BAR;
#undef PG8_SA
#undef PG8_SB
#undef PG8_STAGE
#undef PG8_STAGEA
#undef PG8_STAGEB
#undef PG8_LDA
#undef PG8_LDB
#undef PG8_MMA
#undef PG8_WAIT_V
#undef PG8_WAIT_L
#undef PG8_BAR
#undef PG8_SCHED
}
#else
__device__ __forceinline__ float dot8(const v4u a, const v4u b) {
    return (bflo(a.x) * bflo(b.x) + bfhi(a.x) * bfhi(b.x)) + (bflo(a.y) * bflo(b.y) + bfhi(a.y) * bfhi(b.y)) + (bflo(a.z) * bflo(b.z) + bfhi(a.z) * bfhi(b.z)) + (bflo(a.w) * bflo(b.w) + bfhi(a.w) * bfhi(b.w));
}
template <class Epi, class Sched, bool ALIGN_EPI>
__device__ __forceinline__ void gemm_phase(LAS unsigned char* lds, const Sched& S, const Epi& E) {
    const int tid = threadIdx.x, wid = __builtin_amdgcn_readfirstlane(tid >> 6), lane = tid & 63, wr = wid >> 2, wc = wid & 3, fr = lane & 15, fq = lane >> 4;
    E.fill_scales(S, tid);
    GUnit cur;
    for (int ui = 0; S.next(ui, cur); ++ui) {
        float cs[2][8]; E.prep(cur, ui, wr, wc, fr, fq, cs);
#pragma unroll
        for (int am = 0; am < 8; ++am) {
            const int ai = am >> 2, m = am & 3;
            const char* ap = cur.A + (size_t)(ai * HALF + wr * 64 + m * 16 + fr) * cur.rsA;
            const char* bp = cur.B + (size_t)(wc * 32 + 8 * fq) * cur.rsB;
            float s[2][8];
#pragma unroll
            for (int bj = 0; bj < 2; ++bj)
#pragma unroll
                for (int e = 0; e < 8; ++e) s[bj][e] = 0.f;
#pragma unroll 1
            for (int k8 = 0; k8 < KDIM / 8; ++k8) {
                const v4u av = *(const v4u*)(ap + 16 * k8);
#pragma unroll
                for (int bj = 0; bj < 2; ++bj)
#pragma unroll
                    for (int e = 0; e < 8; ++e) s[bj][e] += dot8(av, *(const v4u*)(bp + (size_t)(bj * HALF + e) * cur.rsB + 16 * k8));
            }
            const f32x4 a[2][2] = {{(f32x4){s[0][0], s[0][1], s[0][2], s[0][3]}, (f32x4){s[0][4], s[0][5], s[0][6], s[0][7]}}, {(f32x4){s[1][0], s[1][1], s[1][2], s[1][3]}, (f32x4){s[1][4], s[1][5], s[1][6], s[1][7]}}};
            E.rowgroup(a, cur, ai, m, wr, wc, fr, fq, cs);
        }
    }
}
#endif

struct Frame {
    LAS unsigned char* lds;
    int tid, lane, wave, vcu, G;
    const float *x, *g0, *w_in0, *rpb, *w_out0, *g1, *w_in1, *w_out1, *gf;
    float* out; unsigned char* ws;
};

__device__ __forceinline__ void p0_transpose_item(const float* W, int N, bf16* WT, int dst0, int src0, int kb, float sc, const float* gk, LAS float* scr, int lane) {
    const int k0 = 64 * kb;
#pragma unroll 8
    for (int i = 0; i < 32; ++i) { const int kk = 2 * i + (lane >> 5); float w = W[(size_t)(k0 + kk) * N + src0 + (lane & 31)] * sc; if (gk) w *= gk[k0 + kk]; scr[kk * 33 + (lane & 31)] = w; }
    LDS_WAIT(); asm volatile("" ::: "memory");
    const int c = lane & 7;
#pragma unroll
    for (int j = 0; j < 4; ++j) { const int n = (lane >> 3) + 8 * j; const LAS float* s = scr + (8 * c) * 33 + n;
        v4u o; o.x = pk2(s[0 * 33], s[1 * 33]); o.y = pk2(s[2 * 33], s[3 * 33]); o.z = pk2(s[4 * 33], s[5 * 33]); o.w = pk2(s[6 * 33], s[7 * 33]);
        *(v4u*)(WT + (size_t)(dst0 + n) * KDIM + k0 + 8 * c) = o; }
    LDS_WAIT(); asm volatile("" ::: "memory");
}
__device__ __forceinline__ void p0_prologue(Frame& F) {
    int tid_ = threadIdx.x; asm volatile("" : "+v"(tid_)); const int lane = tid_ & 63;
    LAS float* scr = (LAS float*)(F.lds + F.wave * 16384);
    const int gw = F.vcu * NWAVES + F.wave, NGW = F.G * NWAVES;
    bf16* WT0 = (bf16*)(F.ws + WS_WT0); bf16* WO0 = (bf16*)(F.ws + WS_WO0); bf16* WT1 = (bf16*)(F.ws + WS_WT1); bf16* WO1 = (bf16*)(F.ws + WS_WO1);
    constexpr int I0 = 128 * 16, I1 = 32 * 16, I2 = 320 * 16, I3 = 32 * 16, NIT = I0 + I1 + I2 + I3;
    for (int it = gw; it < NIT; it += NGW) {
        int r = it;
        if (r < I0) { const int rb = r >> 4, kb = r & 15, d0 = 32 * rb, sec = d0 >> 10, within = d0 & 1023;
            const int srcsec = (sec == 0) ? 0 : (sec == 1) ? 1024 : (sec == 2) ? 3072 : 2048;
            p0_transpose_item(F.w_in0, N0, WT0, d0, srcsec + within, kb, sec == 0 ? QSCALE : 1.0f, nullptr, scr, lane); continue; }
        r -= I0;
        if (r < I1) { const int rb = r >> 4, kb = r & 15; p0_transpose_item(F.w_out0, D, WO0, 32 * rb, 32 * rb, kb, 1.0f, nullptr, scr, lane); continue; }
        r -= I1;
        if (r < I2) { const int rb = r >> 4, kb = r & 15, d0 = 32 * rb, sec = d0 >> 10, within = d0 & 1023;
            int srcsec; if (sec < 6) srcsec = (sec >> 1) * 3072 + (sec & 1) * 1024; else if (sec == 6) srcsec = 9216; else srcsec = (sec - 7) * 3072 + 2048;
            p0_transpose_item(F.w_in1, N1, WT1, d0, srcsec + within, kb, (sec < 6 && !(sec & 1)) ? QSCALE : 1.0f, F.g1, scr, lane); continue; }
        r -= I2;
        { const int rb = r >> 4, kb = r & 15; p0_transpose_item(F.w_out1, D, WO1, 32 * rb, 32 * rb, kb, 1.0f, nullptr, scr, lane); }
    }
    bf16* XB = (bf16*)(F.ws + WS_XB);
    for (int m = gw; m < M; m += NGW) {
        const f32x4* xr = (const f32x4*)(F.x + (size_t)m * D) + lane; const f32x4* gr = (const f32x4*)F.g0 + lane;
        f32x4 v[4]; float s = 0.f;
#pragma unroll
        for (int j = 0; j < 4; ++j) { v[j] = xr[64 * j]; s += (v[j].x * v[j].x + v[j].y * v[j].y) + (v[j].z * v[j].z + v[j].w * v[j].w); }
        const float rstd = __builtin_amdgcn_rsqf(wave_sum(s) * (1.0f / D) + RMS_EPS);
        unsigned long long* o8 = (unsigned long long*)(XB + (size_t)m * D) + lane;
#pragma unroll
        for (int j = 0; j < 4; ++j) { const f32x4 g = gr[64 * j];
            o8[64 * j] = (unsigned long long)pk2(v[j].x * rstd * g.x, v[j].y * rstd * g.y) | ((unsigned long long)pk2(v[j].z * rstd * g.z, v[j].w * rstd * g.w) << 32); }
    }
}

__device__ __forceinline__ float max3f(float a, float b, float c) { return fmaxf(fmaxf(a, b), c); }
template <int N, bool MASKED, class BiasFn>
__device__ __forceinline__ void attn_tiles(f32x4 (&O)[N][4], float (&m)[N], f32x4 (&Lacc)[N], const bf16x8 (&kf)[2][2], const bf16x8 (&vf)[4], const bf16x8 (&qf)[N][2], const BiasFn (&bias)[N], const bool (&act)[N]) {
    f32x4 s[N][2]; float mx[N]; bool need = false;
#pragma unroll
    for (int n = 0; n < N; ++n) {
        f32x4 b0, b1; bias[n].get(b0, b1);
        if (MASKED && !act[n]) { b0 = (f32x4){-3e38f, -3e38f, -3e38f, -3e38f}; b1 = b0; }
#pragma unroll
        for (int hf = 0; hf < 2; ++hf) {
            f32x4 a = __builtin_amdgcn_mfma_f32_16x16x32_bf16(kf[hf][0], qf[n][0], (f32x4){0.f, 0.f, 0.f, 0.f}, 0, 0, 0);
            a = __builtin_amdgcn_mfma_f32_16x16x32_bf16(kf[hf][1], qf[n][1], a, 0, 0, 0);
            s[n][hf] = a + (hf ? b1 : b0);
        }
    }
#pragma unroll
    for (int n = 0; n < N; ++n) {
        mx[n] = fmaxf(max3f(s[n][0][0], s[n][0][1], s[n][0][2]), max3f(max3f(s[n][0][3], s[n][1][0], s[n][1][1]), s[n][1][2], s[n][1][3]));
        need = need || (mx[n] > m[n] + 8.0f);
    }
    if (__builtin_amdgcn_ballot_w64(need) != 0ull) {
#pragma unroll
        for (int n = 0; n < N; ++n) {
            float x = mx[n]; x = fmaxf(x, __shfl_xor(x, 16)); x = fmaxf(x, __shfl_xor(x, 32));
            const float mn_ = fmaxf(m[n], x), al = fast_exp2(m[n] - mn_);
            m[n] = mn_; Lacc[n] = Lacc[n] * al;
#pragma unroll
            for (int dt = 0; dt < 4; ++dt) O[n][dt] = O[n][dt] * al;
        }
    }
    bf16x8 pb[N];
#pragma unroll
    for (int n = 0; n < N; ++n) {
        const f32x4 e0 = s[n][0] - m[n], e1 = s[n][1] - m[n];
        v4u w; w.x = cvt_pk_bf16(fast_exp2(e0[0]), fast_exp2(e0[1])); w.y = cvt_pk_bf16(fast_exp2(e0[2]), fast_exp2(e0[3]));
        w.z = cvt_pk_bf16(fast_exp2(e1[0]), fast_exp2(e1[1])); w.w = cvt_pk_bf16(fast_exp2(e1[2]), fast_exp2(e1[3]));
        pb[n] = __builtin_bit_cast(bf16x8, w);
    }
    const bf16x8 ones = {0x3f80, 0x3f80, 0x3f80, 0x3f80, 0x3f80, 0x3f80, 0x3f80, 0x3f80};
#pragma unroll
    for (int n = 0; n < N; ++n) {
#pragma unroll
        for (int dt = 0; dt < 4; ++dt) O[n][dt] = __builtin_amdgcn_mfma_f32_16x16x32_bf16(vf[dt], pb[n], O[n][dt], 0, 0, 0);
        Lacc[n] = __builtin_amdgcn_mfma_f32_16x16x32_bf16(ones, pb[n], Lacc[n], 0, 0, 0);
    }
}
struct KVBuf { bf16x8 kf[2][2]; bf16x8 vf[4]; };
#define RING_ISSUE(slot_, kp_, khs_, vp_, vds_) do { \
        _Pragma("unroll") for (int hf_ = 0; hf_ < 2; ++hf_) _Pragma("unroll") for (int kk_ = 0; kk_ < 2; ++kk_) \
            __builtin_amdgcn_global_load_lds((const unsigned*)((const char*)(kp_) + (size_t)hf_ * (khs_) + kk_ * 16), (LAS unsigned*)(ringW + (slot_) * 8192 + (hf_ * 2 + kk_) * 1024), 16, 0, 0); \
        _Pragma("unroll") for (int dt_ = 0; dt_ < 4; ++dt_) \
            __builtin_amdgcn_global_load_lds((const unsigned*)((const char*)(vp_) + (size_t)dt_ * (vds_)), (LAS unsigned*)(ringW + (slot_) * 8192 + (4 + dt_) * 1024), 16, 0, 0); } while (0)
#define RING_READ(buf_, slot_) do { \
        _Pragma("unroll") for (int hf_ = 0; hf_ < 2; ++hf_) _Pragma("unroll") for (int kk_ = 0; kk_ < 2; ++kk_) buf_.kf[hf_][kk_] = *(const LAS bf16x8*)(ringW + (slot_) * 8192 + (hf_ * 2 + kk_) * 1024 + lane * 16); \
        _Pragma("unroll") for (int dt_ = 0; dt_ < 4; ++dt_) buf_.vf[dt_] = *(const LAS bf16x8*)(ringW + (slot_) * 8192 + (4 + dt_) * 1024 + lane * 16); } while (0)

#if FAST_ATTN_A
struct BiasA { const LAS float* br; const int* coff; unsigned val;
    __device__ __forceinline__ void get(f32x4& b0, f32x4& b1) const {
#pragma unroll
        for (int j = 0; j < 4; ++j) { const float x0 = br[coff[j]], x1 = br[coff[4 + j]]; b0[j] = ((val >> j) & 1u) ? x0 : -3e38f; b1[j] = ((val >> (4 + j)) & 1u) ? x1 : -3e38f; } } };
__device__ __forceinline__ void attn_a_phase(Frame& F) {
    int tid_ = threadIdx.x; asm volatile("" : "+v"(tid_));
    const int lane = tid_ & 63, wave = __builtin_amdgcn_readfirstlane(tid_ >> 6), q = lane & 15, g = lane >> 4;
    const bf16* QK = (const bf16*)(F.ws + WS_QK0); const bf16* G0 = (const bf16*)(F.ws + WS_G0); const bf16* VT = (const bf16*)(F.ws + WS_VT0); bf16* OG = (bf16*)(F.ws + WS_OG0);
    const int pair = F.vcu >> 3, strip = F.vcu & 7, b = pair >> 4, h = pair & 15;
    LAS unsigned char* ringW = F.lds + wave * 16384;
    LAS float* rpbL = (LAS float*)(F.lds + SC_OFF);
    for (int i = tid_; i < 15 * 31; i += NWAVES * 64) rpbL[i] = F.rpb[h * 15 * 31 + i] * LOG2E;
    __syncthreads();
    const int blk = wave & 3, kb = min(max(blk * 16 - 8, 0), 32);
    const int drow = 16 * (q >> 2) + (q & 3), kap = 8 * (q >> 2) + (q & 3);
    const int qcol = blk * 16 + q, cst = min(max(qcol - 8, 0), 48);
    int coff[8]; unsigned val = 0u;
#pragma unroll
    for (int i = 0; i < 8; ++i) { const int kc = kb + 8 * g + i; if (kc >= cst && kc < cst + 16) val |= 1u << i; coff[i] = min(max(kc - qcol + 15, 0), 30); }
    const bf16* kbase = QK + ((size_t)(H + h) * M + (size_t)b * SEQ + kb + kap) * 64 + 16 * g;
    const bf16* vbase = VT + (((size_t)h * (M / 64) + (size_t)b * (SEQ / 64)) * 64 + drow) * 64 + kb + 8 * g;
    constexpr size_t KHS = 4 * 128, VDS = 4 * 128, KRS = 64 * 64;
#pragma unroll 1
    for (int gi = 0; gi < 2; ++gi) {
        const int R = strip * 16 + (wave >> 2) * 8 + 4 * gi;
        int rs[4]; bf16x8 qf[4][2];
#pragma unroll
        for (int i = 0; i < 4; ++i) { rs[i] = min(max(R + i - 4, 0), 120);
            const bf16* qp = QK + ((size_t)h * M + (size_t)b * SEQ + (R + i) * 64 + blk * 16 + q) * 64 + 16 * g; qf[i][0] = *(const bf16x8*)qp; qf[i][1] = *(const bf16x8*)(qp + 8); }
        const int lo = rs[0], hi = rs[3] + 7;
        f32x4 O[4][4]; float mm[4]; f32x4 ll[4];
#pragma unroll
        for (int i = 0; i < 4; ++i) { mm[i] = -1e30f; ll[i] = (f32x4){0.f, 0.f, 0.f, 0.f};
#pragma unroll
            for (int dt = 0; dt < 4; ++dt) O[i][dt] = (f32x4){0.f, 0.f, 0.f, 0.f}; }
        asm volatile("s_waitcnt vmcnt(0)" ::: "memory");
        RING_ISSUE(0, kbase + (size_t)lo * KRS, KHS, vbase + (size_t)lo * KRS, VDS);
        { const int k1 = min(lo + 1, hi); RING_ISSUE(1, kbase + (size_t)k1 * KRS, KHS, vbase + (size_t)k1 * KRS, VDS); }
#pragma unroll 1
        for (int kr = lo; kr <= hi; ++kr) {
            const int slot = (kr - lo) & 1;
            KVBuf buf;
            asm volatile("s_waitcnt vmcnt(8)" ::: "memory");
            RING_READ(buf, slot);
            asm volatile("s_waitcnt lgkmcnt(0)" ::: "memory"); __builtin_amdgcn_sched_barrier(0);
            { const int k2 = min(kr + 2, hi); RING_ISSUE(slot, kbase + (size_t)k2 * KRS, KHS, vbase + (size_t)k2 * KRS, VDS); }
#pragma unroll
            for (int i = 0; i < 4; i += 2) {
                const bool act_[2] = {kr >= rs[i] && kr <= rs[i] + 7, kr >= rs[i + 1] && kr <= rs[i + 1] + 7};
                if (act_[0] || act_[1]) {
                    const BiasA bf_[2] = {{rpbL + min(max(kr - (R + i) + 7, 0), 14) * 31, coff, val}, {rpbL + min(max(kr - (R + i + 1) + 7, 0), 14) * 31, coff, val}};
                    attn_tiles<2, true>(*(f32x4 (*)[2][4])&O[i], *(float (*)[2])&mm[i], *(f32x4 (*)[2])&ll[i], buf.kf, buf.vf, *(const bf16x8 (*)[2][2])&qf[i], bf_, act_); }
            }
        }
        asm volatile("s_waitcnt vmcnt(0)" ::: "memory");
#pragma unroll
        for (int i = 0; i < 4; ++i) {
            const float inv = __builtin_amdgcn_rcpf(ll[i][0]);
            const size_t tokq = (size_t)b * SEQ + (R + i) * 64 + blk * 16 + q;
            const bf16* gp = G0 + tokq * D + h * 64 + 16 * g;
            const v4u g0 = *(const v4u*)gp, g1 = *(const v4u*)(gp + 8);
            const unsigned gw[8] = {g0.x, g0.y, g0.z, g0.w, g1.x, g1.y, g1.z, g1.w};
            unsigned ow[8];
#pragma unroll
            for (int dt = 0; dt < 4; ++dt) {
                const float a0 = O[i][dt][0] * inv * silu_f(bflo(gw[2 * dt])), a1 = O[i][dt][1] * inv * silu_f(bfhi(gw[2 * dt]));
                const float a2 = O[i][dt][2] * inv * silu_f(bflo(gw[2 * dt + 1])), a3 = O[i][dt][3] * inv * silu_f(bfhi(gw[2 * dt + 1]));
                ow[2 * dt] = cvt_pk_bf16(a0, a1); ow[2 * dt + 1] = cvt_pk_bf16(a2, a3);
            }
            bf16* op = OG + tokq * D + h * 64 + 16 * g;
            *(v4u*)op = (v4u){ow[0], ow[1], ow[2], ow[3]}; *(v4u*)(op + 8) = (v4u){ow[4], ow[5], ow[6], ow[7]};
        }
    }
}
#else
__device__ __forceinline__ void attn_a_phase(Frame& F) {
    const bf16* QK = (const bf16*)(F.ws + WS_QK0); const bf16* G0 = (const bf16*)(F.ws + WS_G0); const bf16* VT = (const bf16*)(F.ws + WS_VT0); bf16* OG = (bf16*)(F.ws + WS_OG0);
    const int gw = F.vcu * NWAVES + F.wave, NGW = F.G * NWAVES, lane = F.lane;
    for (int it = gw; it < M * H; it += NGW) {
        const int tok = it >> 4, h = it & 15, b = tok >> 13, t = tok & 8191, r = t >> 6, c = t & 63;
        const int rs = min(max(r - 4, 0), 120), cs = min(max(c - 8, 0), 48);
        const float qd = bf2f(QK[((size_t)h * M + tok) * 64 + lane]);
        float m = -1e30f, l = 0.f, o = 0.f;
        for (int kr = 0; kr < 8; ++kr)
            for (int kc = 0; kc < 16; ++kc) {
                const int ktok = (b << 13) + (rs + kr) * 64 + cs + kc;
                const float s = wave_sum(qd * bf2f(QK[((size_t)(H + h) * M + ktok) * 64 + lane])) + F.rpb[(h * 15 + (rs + kr - r + 7)) * 31 + (cs + kc - c + 15)] * LOG2E;
                const float mn = fmaxf(m, s), al = fast_exp2(m - mn), p = fast_exp2(s - mn);
                l = l * al + p; o = o * al + p * bf2f(VT[(((size_t)h * (M / 64) + (ktok >> 6)) * 64 + lane) * 64 + (ktok & 63)]); m = mn;
            }
        const float g = bf2f(G0[(size_t)tok * D + h * 64 + lane]);
        OG[(size_t)tok * D + h * 64 + lane] = (bf16)f2bf(o / l * silu_f(g));
    }
}
#endif

#if FAST_ATTN_B
struct BiasB { const LAS float* tp;
    __device__ __forceinline__ void get(f32x4& b0, f32x4& b1) const { b0 = *(const LAS f32x4*)tp; b1 = *(const LAS f32x4*)(tp + 4); } };
__device__ __forceinline__ void attn_b_pass(Frame& F, LAS unsigned char* ring, int tid, float* LSE, bf16* QK, const bf16* G1, const bf16* VT, bf16* OG, int h, int grp, int rr, int P0, float slope2) {
    const int lane = tid & 63, wave = __builtin_amdgcn_readfirstlane(tid >> 6), q = lane & 15, g4 = lane >> 4;
    const int sh = 2 * grp, dil = 1 << sh, L = SEQ >> sh;
    bf16* Qg = QK + ((size_t)(2 * grp * H + h) * SEQ + rr * L) * 64;
    const char* Kg = (const char*)(Qg + (size_t)H * SEQ * 64);
    const char* Vg = (const char*)(VT + ((size_t)(grp * H + h) * (SEQ / 32) + (rr * L) / 32) * 2048);
    unsigned srcoff;
    const char* srcbase;
    if (wave < 4) { const int key = 8 * wave + (lane >> 3), p = lane & 7, c = p ^ (((key >> 3) & 3) | (((key >> 1) & 1) << 2)); srcoff = key * 128 + c * 16; srcbase = Kg; }
    else { const int pv = wave - 4, d = 16 * pv + (lane >> 2), p = lane & 3, gk = p ^ pv; srcoff = d * 64 + gk * 16; srcbase = Vg; }
    const int key0 = 8 * (q >> 2) + (q & 3);
    const int sk = ((key0 >> 3) & 3) | (((key0 >> 1) & 1) << 2);
    const int koff0 = key0 * 128 + (((2 * g4) ^ sk) << 4), koff1 = key0 * 128 + (((2 * g4 + 1) ^ sk) << 4);
    const int d0 = 16 * (q >> 2) + (q & 3);
    const int voff = 4096 + d0 * 64 + ((g4 ^ (q >> 2)) << 4);
    LAS unsigned char* qL = ring + 53248 + wave * 8192 + lane * 16;
    { bf16x8 qf[4][2];
#pragma unroll
    for (int i = 0; i < 4; ++i) { const bf16* qp = Qg + (size_t)(P0 + 16 * (2 * wave + (i & 1) + 16 * (i >> 1)) + q) * 64 + 16 * g4; qf[i][0] = *(const bf16x8*)qp; qf[i][1] = *(const bf16x8*)(qp + 8); }
#pragma unroll
    for (int i = 0; i < 4; ++i) { *(LAS bf16x8*)(qL + (2 * i) * 1024) = qf[i][0]; *(LAS bf16x8*)(qL + (2 * i + 1) * 1024) = qf[i][1]; } }
    f32x4 O[4][4]; float mm[4]; f32x4 ll[4];
#pragma unroll
    for (int i = 0; i < 4; ++i) { mm[i] = -1e30f; ll[i] = (f32x4){0.f, 0.f, 0.f, 0.f};
#pragma unroll
        for (int dt = 0; dt < 4; ++dt) O[i][dt] = (f32x4){0.f, 0.f, 0.f, 0.f}; }
    asm volatile("s_waitcnt vmcnt(0) lgkmcnt(0)" ::: "memory");
    __builtin_amdgcn_s_barrier(); asm volatile("" ::: "memory");
    LAS float* tabL = (LAS float*)(ring + 32768);
    { const float sl = slope2 * (float)dil;
      for (int i = tid; i < 10 * 64 * 8; i += NWAVES * 64) { const int e = i & 7, ln = (i >> 3) & 63, dc = i >> 9; const int dj = 16 * (dc - 1) - 64 + 8 * (ln >> 4) + e - (ln & 15), ad = dj < 0 ? -dj : dj;
          tabL[i] = ad <= 64 ? -sl * (float)ad : -3e38f; } }
    asm volatile("s_waitcnt lgkmcnt(0)" ::: "memory");
    __builtin_amdgcn_s_barrier(); asm volatile("" ::: "memory");
    const LAS float* tabW = tabL + lane * 8;
#define BP_ISSUE(s_) do { const int pc_ = min(max(P0 - 64 + 32 * (s_), 0), L - 32); \
        __builtin_amdgcn_global_load_lds((const unsigned*)(srcbase + (size_t)pc_ * 128 + srcoff), (LAS unsigned*)(ring + ((s_) & 3) * 8192 + wave * 1024), 16, 0, 0); } while (0)
    BP_ISSUE(0); BP_ISSUE(1); BP_ISSUE(2);
#pragma unroll 1
    for (int s = 0; s < 20; ++s) {
        asm volatile("s_waitcnt vmcnt(2)" ::: "memory");
        __builtin_amdgcn_s_barrier();
        asm volatile("" ::: "memory");
        BP_ISSUE(s + 3);
        const int p0 = P0 - 64 + 32 * s;
        if (p0 >= 0 && p0 < L) {
            const LAS unsigned char* sl_ = ring + (s & 3) * 8192;
            KVBuf buf;
#pragma unroll
            for (int hf = 0; hf < 2; ++hf) { buf.kf[hf][0] = *(const LAS bf16x8*)(sl_ + koff0 + hf * 512); buf.kf[hf][1] = *(const LAS bf16x8*)(sl_ + koff1 + hf * 512); }
#pragma unroll
            for (int dt = 0; dt < 4; ++dt) buf.vf[dt] = *(const LAS bf16x8*)(sl_ + voff + dt * 256);
            asm volatile("s_waitcnt lgkmcnt(0)" ::: "memory"); __builtin_amdgcn_sched_barrier(0);
#pragma unroll
            for (int i = 0; i < 4; i += 2) { const int T = 2 * wave + 8 * i;
                if (T >= 2 * s - 8 && T <= 2 * s) { const BiasB bf_[2] = {{tabW + (2 * s - T + 1) * 512}, {tabW + (2 * s - T) * 512}}; const bool act_[2] = {true, true};
                    const bf16x8 qp_[2][2] = {{*(const LAS bf16x8*)(qL + (2 * i) * 1024), *(const LAS bf16x8*)(qL + (2 * i + 1) * 1024)}, {*(const LAS bf16x8*)(qL + (2 * i + 2) * 1024), *(const LAS bf16x8*)(qL + (2 * i + 3) * 1024)}};
                    attn_tiles<2, false>(*(f32x4 (*)[2][4])&O[i], *(float (*)[2])&mm[i], *(f32x4 (*)[2])&ll[i], buf.kf, buf.vf, qp_, bf_, act_); } }
        }
    }
#undef BP_ISSUE
    asm volatile("s_waitcnt vmcnt(0)" ::: "memory");
#pragma unroll
    for (int i = 0; i < 4; ++i) {
        const int pos = P0 + 16 * (2 * wave + (i & 1) + 16 * (i >> 1)) + q, tl = pos * dil + rr;
        const float ls = ll[i][0];
        const float inv = __builtin_amdgcn_rcpf(ls), lse = mm[i] + __builtin_amdgcn_logf(ls);
        if (grp < 2) {
            unsigned ow[8];
#pragma unroll
            for (int dt = 0; dt < 4; ++dt) { ow[2 * dt] = cvt_pk_bf16(O[i][dt][0] * inv, O[i][dt][1] * inv); ow[2 * dt + 1] = cvt_pk_bf16(O[i][dt][2] * inv, O[i][dt][3] * inv); }
            bf16* xp = Qg + (size_t)pos * 64 + 16 * g4;
            *(v4u*)xp = (v4u){ow[0], ow[1], ow[2], ow[3]}; *(v4u*)(xp + 8) = (v4u){ow[4], ow[5], ow[6], ow[7]};
            if (g4 == 0) LSE[(size_t)(grp * SEQ + tl) * H + h] = lse;
        } else {
            const float l0 = __builtin_nontemporal_load(LSE + (size_t)tl * H + h), l1 = __builtin_nontemporal_load(LSE + (size_t)(SEQ + tl) * H + h);
            const float mx = fmaxf(lse, fmaxf(l0, l1));
            const float w0 = fast_exp2(l0 - mx), w1 = fast_exp2(l1 - mx), w2 = fast_exp2(lse - mx);
            const float wn = __builtin_amdgcn_rcpf(w0 + w1 + w2), c0 = w0 * wn, c1 = w1 * wn, c2 = w2 * wn * inv;
            const bf16* x0 = QK + ((size_t)h * SEQ + tl) * 64 + 16 * g4;
            const bf16* x1 = QK + ((size_t)(2 * H + h) * SEQ + (tl & 3) * (SEQ / 4) + (tl >> 2)) * 64 + 16 * g4;
            const v4u a0 = __builtin_nontemporal_load((const v4u*)x0), a1 = __builtin_nontemporal_load((const v4u*)(x0 + 8));
            const v4u b0 = __builtin_nontemporal_load((const v4u*)x1), b1 = __builtin_nontemporal_load((const v4u*)(x1 + 8));
            const unsigned aw[8] = {a0.x, a0.y, a0.z, a0.w, a1.x, a1.y, a1.z, a1.w}, bw[8] = {b0.x, b0.y, b0.z, b0.w, b1.x, b1.y, b1.z, b1.w};
            const bf16* gp = G1 + (size_t)tl * D + h * 64 + 16 * g4;
            const v4u gg0 = *(const v4u*)gp, gg1 = *(const v4u*)(gp + 8);
            const unsigned gw[8] = {gg0.x, gg0.y, gg0.z, gg0.w, gg1.x, gg1.y, gg1.z, gg1.w};
            unsigned ow[8];
#pragma unroll
            for (int dt = 0; dt < 4; ++dt) {
                const float e0 = c0 * bflo(aw[2 * dt]) + c1 * bflo(bw[2 * dt]) + c2 * O[i][dt][0], e1 = c0 * bfhi(aw[2 * dt]) + c1 * bfhi(bw[2 * dt]) + c2 * O[i][dt][1];
                const float e2 = c0 * bflo(aw[2 * dt + 1]) + c1 * bflo(bw[2 * dt + 1]) + c2 * O[i][dt][2], e3 = c0 * bfhi(aw[2 * dt + 1]) + c1 * bfhi(bw[2 * dt + 1]) + c2 * O[i][dt][3];
                ow[2 * dt] = cvt_pk_bf16(e0 * silu_f(bflo(gw[2 * dt])), e1 * silu_f(bfhi(gw[2 * dt])));
                ow[2 * dt + 1] = cvt_pk_bf16(e2 * silu_f(bflo(gw[2 * dt + 1])), e3 * silu_f(bfhi(gw[2 * dt + 1])));
            }
            bf16* op = OG + (size_t)tl * D + h * 64 + 16 * g4;
            *(v4u*)op = (v4u){ow[0], ow[1], ow[2], ow[3]}; *(v4u*)(op + 8) = (v4u){ow[4], ow[5], ow[6], ow[7]};
        }
    }
}
__device__ __forceinline__ void attn_b_phase(Frame& F, int b, int part) {
    int tid_ = threadIdx.x; asm volatile("" : "+v"(tid_));
    bf16* QK = (bf16*)(F.ws + WS_QK1); const bf16* G1 = (const bf16*)(F.ws + WS_G1); const bf16* VT = (const bf16*)(F.ws + WS_VT1); bf16* OG = (bf16*)(F.ws + (b == 0 ? WS_OG1A : WS_OG1B));
    float* LSE = (float*)(F.ws + WS_LSE);
    const int h = F.vcu >> 4, j = F.vcu & 15;
    const float slope2 = exp2f(-0.5f * (float)(h + 1)) * LOG2E;
    if (part == 0) {
        attn_b_pass(F, F.lds, tid_, LSE, QK, G1, VT, OG, h, 0, 0, 512 * j, slope2);
        attn_b_pass(F, F.lds, tid_, LSE, QK, G1, VT, OG, h, 1, j >> 2, 512 * (j & 3), slope2);
    } else {
        attn_b_pass(F, F.lds, tid_, LSE, QK, G1, VT, OG, h, 2, j, 0, slope2);
    }
}
#else
__device__ __forceinline__ void attn_b_phase(Frame& F, int b, int part) {
    if (part) return;
    const bf16* QK = (const bf16*)(F.ws + WS_QK1); const bf16* G1 = (const bf16*)(F.ws + WS_G1); const bf16* VT = (const bf16*)(F.ws + WS_VT1); bf16* OG = (bf16*)(F.ws + (b == 0 ? WS_OG1A : WS_OG1B));
    const int gw = F.vcu * NWAVES + F.wave, NGW = F.G * NWAVES, lane = F.lane;
    for (int it = gw; it < SEQ * H; it += NGW) {
        const int tl = it >> 4, h = it & 15;
        const float slope2 = exp2f(-0.5f * (float)(h + 1)) * LOG2E;
        float og[3], lse[3];
#pragma unroll
        for (int g = 0; g < 3; ++g) {
            const int sh = 2 * g, dil = 1 << sh, L = SEQ >> sh, i = tl >> sh, rr = tl & (dil - 1);
            const float qd = bf2f(QK[((size_t)(2 * g * H + h) * SEQ + rr * L + i) * 64 + lane]);
            float m = -1e30f, l = 0.f, o = 0.f;
            for (int j = -64; j <= 64; ++j) {
                const int ki = i + j; if (ki < 0 || ki >= L) continue;
                const float s = wave_sum(qd * bf2f(QK[((size_t)((2 * g + 1) * H + h) * SEQ + rr * L + ki) * 64 + lane])) - slope2 * (float)(abs(j) * dil);
                const float mn = fmaxf(m, s), al = fast_exp2(m - mn), p = fast_exp2(s - mn);
                l = l * al + p; o = o * al + p * bf2f(VT[(((size_t)(g * H + h) * (SEQ / 32) + ((rr * L + ki) >> 5)) * 64 + lane) * 32 + ((rr * L + ki) & 31)]); m = mn;
            }
            og[g] = o / l; lse[g] = m + log2f(l);
        }
        const float mx = fmaxf(lse[0], fmaxf(lse[1], lse[2]));
        const float w0 = fast_exp2(lse[0] - mx), w1 = fast_exp2(lse[1] - mx), w2 = fast_exp2(lse[2] - mx);
        const float o = (w0 * og[0] + w1 * og[1] + w2 * og[2]) / (w0 + w1 + w2);
        const float g = bf2f(G1[(size_t)tl * D + h * 64 + lane]);
        OG[(size_t)tl * D + h * 64 + lane] = (bf16)f2bf(o * silu_f(g));
    }
}
#endif

__device__ __forceinline__ void final_phase(Frame& F) {
    int tid_ = threadIdx.x; asm volatile("" : "+v"(tid_)); const int lane = tid_ & 63;
    const float* ss = (const float*)(F.ws + WS_SS2);
    const int gw = F.vcu * NWAVES + F.wave, NGW = F.G * NWAVES;
    for (int m = gw; m < M; m += NGW) {
        float s = (lane < 16) ? ss[(size_t)lane * M + m] : 0.f;
        const float rstd = __builtin_amdgcn_rsqf(wave_sum(s) * (1.0f / D) + RMS_EPS);
        f32x4* xr = (f32x4*)(F.out + (size_t)m * D) + lane; const f32x4* gr = (const f32x4*)F.gf + lane;
#pragma unroll
        for (int j = 0; j < 4; ++j) { const f32x4 v = xr[64 * j], g = gr[64 * j]; xr[64 * j] = v * rstd * g; }
    }
}

struct Args { const float* in[9]; float* out; unsigned char* ws; };
__global__ void __launch_bounds__(NWAVES * 64, 2) fwd_megakernel(Args args) {
    extern __shared__ __attribute__((aligned(16))) unsigned char lds_raw[];
    Frame F;
    F.lds = (LAS unsigned char*)lds_raw;
    F.tid = threadIdx.x; F.lane = F.tid & 63; F.wave = __builtin_amdgcn_readfirstlane(F.tid >> 6);
    F.G = gridDim.x; { const int bx = blockIdx.x; F.vcu = (F.G % 8 == 0) ? (bx % 8) * (F.G / 8) + bx / 8 : bx; }
    F.x = args.in[0]; F.g0 = args.in[1]; F.w_in0 = args.in[2]; F.rpb = args.in[3]; F.w_out0 = args.in[4]; F.g1 = args.in[5]; F.w_in1 = args.in[6]; F.w_out1 = args.in[7]; F.gf = args.in[8];
    F.out = args.out; F.ws = args.ws;
    volatile LAS unsigned* MISC = (volatile LAS unsigned*)(F.lds + MISC_OFF);
    for (int u = F.tid; u < 128; u += NWAVES * 64) MISC[u] = 0u;
    __syncthreads();
    XcdBarrier bar = xcd_barrier_post((unsigned*)(F.ws + WS_CTL), MISC + 8);
#define GRID_BAR() xcd_barrier(bar)
    const int G = F.G, c = (int)blockIdx.x;

    for (int rep = 0; rep < REP_P0; ++rep) { p0_prologue(F); GRID_BAR(); }
    for (int rep = 0; rep < REP_G1; ++rep) {
        ProjSched S{64, 16, 12, G, c, 0, (const char*)(F.ws + WS_XB), (const char*)(F.ws + WS_WT0), 3072};
        EpiProj E{(bf16*)(F.ws + WS_QK0), (bf16*)(F.ws + WS_G0), (bf16*)(F.ws + WS_VT0), 12, M, 64, nullptr, 0, 0, (const LAS float*)(F.lds + SC_OFF)};
        gemm_phase<EpiProj, ProjSched, true>(F.lds, S, E);
        GRID_BAR();
    }
    for (int rep = 0; rep < REP_A0; ++rep) { attn_a_phase(F); GRID_BAR(); }
    for (int rep = 0; rep < REP_G2; ++rep) {
        OutSched S{64, 4, G, c, (const char*)(F.ws + WS_OG0), (const char*)(F.ws + WS_OG0), 64, (const char*)(F.ws + WS_WO0)};
        EpiRes E{F.x, F.out, (bf16*)(F.ws + WS_XB), (float*)(F.ws + WS_SS1)};
        gemm_phase<EpiRes, OutSched, false>(F.lds, S, E);
        GRID_BAR();
    }
#pragma unroll
    for (int b = 0; b < BATCH; ++b) {
        for (int rep = 0; rep < REP_G3; ++rep) {
            ProjSched S{32, 40, 28, G, c, 1, (const char*)(F.ws + WS_XB) + (size_t)b * SEQ * KDIM * 2, (const char*)(F.ws + WS_WT1), 7168};
            EpiProj E{(bf16*)(F.ws + WS_QK1), (bf16*)(F.ws + WS_G1), (bf16*)(F.ws + WS_VT1), 28, SEQ, 32, (const float*)(F.ws + WS_SS1), b * SEQ, 1, (const LAS float*)(F.lds + SC_OFF)};
            gemm_phase<EpiProj, ProjSched, true>(F.lds, S, E);
            GRID_BAR();
        }
        attn_b_phase(F, b, 0); GRID_BAR();
        for (int rep = 0; rep < REP_A1; ++rep) { attn_b_phase(F, b, 1); GRID_BAR(); }
    }
    {
        OutSched S{64, 4, G, c, (const char*)(F.ws + WS_OG1A), (const char*)(F.ws + WS_OG1B), 32, (const char*)(F.ws + WS_WO1)};
        EpiRes E{F.out, F.out, nullptr, (float*)(F.ws + WS_SS2)};
        gemm_phase<EpiRes, OutSched, false>(F.lds, S, E);
    }
    GRID_BAR();
    final_phase(F);
}

extern "C" void kernel_launch(void* const* d_in, const int* in_sizes, int n_in, void* d_out, int out_size, void* d_ws, size_t ws_size, hipStream_t stream) {
    static int grid = 0;
    if (grid == 0) {
        if (n_in != 9 || in_sizes[0] != M * D || out_size != M * D || ws_size < WS_END) {
            fprintf(stderr, "kernel_launch: unexpected shapes (n_in %d, in0 %d, out %d, ws %zu); nothing launched\n", n_in, n_in > 0 ? in_sizes[0] : -1, out_size, ws_size); grid = -1; return; }
        int dev = 0, cus = 0, per_cu = 0;
        if (hipGetDevice(&dev) != hipSuccess || hipDeviceGetAttribute(&cus, hipDeviceAttributeMultiprocessorCount, dev) != hipSuccess) { grid = -1; return; }
        if (hipFuncSetAttribute((const void*)fwd_megakernel, hipFuncAttributeMaxDynamicSharedMemorySize, LDS_BYTES) != hipSuccess) { fprintf(stderr, "kernel_launch: hipFuncSetAttribute failed\n"); grid = -1; return; }
        if (hipOccupancyMaxActiveBlocksPerMultiprocessor(&per_cu, (const void*)fwd_megakernel, NWAVES * 64, LDS_BYTES) != hipSuccess || per_cu < 1) {
            fprintf(stderr, "kernel_launch: occupancy query says %d blocks per CU; nothing launched\n", per_cu); (void)hipGetLastError(); grid = -1; return; }
        grid = cus;
        if (grid != 256) fprintf(stderr, "kernel_launch: note: %d CUs (tuned for 256)\n", grid);
    }
    if (grid < 0) return;
    if (hipMemsetAsync((char*)d_ws + WS_CTL, 0, CTL_ZERO_BYTES, stream) != hipSuccess) return;
    Args a{};
    for (int i = 0; i < 9; ++i) a.in[i] = (const float*)d_in[i];
    a.out = (float*)d_out; a.ws = (unsigned char*)d_ws;
    void* kargs[] = {&a};
    const hipError_t e = hipLaunchCooperativeKernel((const void*)fwd_megakernel, dim3(grid), dim3(NWAVES * 64), kargs, LDS_BYTES, stream);
    if (e != hipSuccess) fprintf(stderr, "kernel_launch: cooperative launch failed: %s (grid %d)\n", hipGetErrorString(e), grid);
}
```
